# Optimizing an MI355X kernel written in HIP

```python
import jax, jax.numpy as jnp
from jax import lax
import numpy as np

D_MODEL = 1024
BATCH = 32
SEQ = 2048
DEPTH = 4

CHUNK = 64
D_FF = 2816
SSD_WIDTH = D_MODEL // 2
SSD_HEAD_DIM = 64
SSD_HEADS = SSD_WIDTH // SSD_HEAD_DIM
SSD_GROUPS = 2
SSD_STATE = 64
SSD_CONV = 4
SSD_CONV_DIM = SSD_WIDTH + 2 * SSD_GROUPS * SSD_STATE
HG_WIDTH = D_MODEL - SSD_WIDTH
HG_HEADS = 8
HG_VAL_HEAD = HG_WIDTH // HG_HEADS
HG_KEY_HEAD = 64
HG_KEY_DIM = HG_HEADS * HG_KEY_HEAD
HG_CHUNK = 16
D_MIX = SSD_WIDTH + HG_WIDTH
D_PROJ = SSD_WIDTH + SSD_CONV_DIM + SSD_HEADS + 2 * HG_KEY_DIM + 2 * HG_WIDTH
NORM_EPS = 1e-6

kernel_name = "hymba_ssd_hgrn2_macaron_trunk"


def rmsnorm(x, w):
    xf = x.astype(jnp.float32)
    xf = xf * lax.rsqrt(jnp.mean(xf * xf, axis=-1, keepdims=True) + NORM_EPS)
    return (xf * w.astype(jnp.float32)).astype(x.dtype)


def swiglu(h, w_gate, w_up, w_down):
    return (jax.nn.silu(h @ w_gate) * (h @ w_up)) @ w_down


def chunk_state_scan(decay, contrib):
    decay_t = jnp.moveaxis(decay, 1, 0)
    contrib_t = jnp.moveaxis(contrib, 1, 0)

    def step(state, inp):
        d, c = inp
        return d * state + c, state

    _, prev = lax.scan(step, jnp.zeros_like(contrib_t[0]), (decay_t, contrib_t))
    return jnp.moveaxis(prev, 0, 1)


def causal_depthwise_conv(u, w, b):
    L = u.shape[1]
    upad = jnp.pad(u, ((0, 0), (SSD_CONV - 1, 0), (0, 0)))
    out = sum(upad[:, k:k + L] * w[k] for k in range(SSD_CONV))
    return out + b


def ssd_mixer(z, xbc_raw, dt_raw, conv_w, conv_b, dt_bias, a_log, d_skip, norm_w):
    Bsz, L, _ = z.shape
    nc = L // CHUNK
    R = SSD_HEADS // SSD_GROUPS
    xbc = jax.nn.silu(causal_depthwise_conv(xbc_raw, conv_w, conv_b))
    xs, Bm, Cm = jnp.split(xbc, [SSD_WIDTH, SSD_WIDTH + SSD_GROUPS * SSD_STATE], axis=-1)
    dt = jax.nn.softplus(dt_raw + dt_bias)
    A = -jnp.exp(a_log).reshape(SSD_GROUPS, R)
    xs = xs.reshape(Bsz, nc, CHUNK, SSD_GROUPS, R, SSD_HEAD_DIM)
    Bm = Bm.reshape(Bsz, nc, CHUNK, SSD_GROUPS, SSD_STATE)
    Cm = Cm.reshape(Bsz, nc, CHUNK, SSD_GROUPS, SSD_STATE)
    dt = dt.reshape(Bsz, nc, CHUNK, SSD_GROUPS, R)
    x_dt = xs * dt[..., None]
    a_cum = jnp.cumsum(dt * A, axis=2)
    causal = jnp.tril(jnp.ones((CHUNK, CHUNK), dtype=bool))[None, None, :, :, None, None]
    seg = a_cum[:, :, :, None] - a_cum[:, :, None, :]
    decay_ts = jnp.where(causal, jnp.exp(jnp.where(causal, seg, 0.0)), 0.0)
    cb = jnp.einsum('bctgn,bcsgn->bctsg', Cm, Bm)
    y_intra = jnp.einsum('bctsg,bctsgr,bcsgrp->bctgrp', cb, decay_ts, x_dt)
    decay_end = jnp.exp(a_cum[:, :, -1:] - a_cum)
    contrib = jnp.einsum('bcsgn,bcsgr,bcsgrp->bcgrpn', Bm, decay_end, x_dt)
    chunk_decay = jnp.exp(a_cum[:, :, -1])[..., None, None]
    s_prev = chunk_state_scan(chunk_decay, contrib)
    y_inter = jnp.einsum('bctgn,bcgrpn,bctgr->bctgrp', Cm, s_prev, jnp.exp(a_cum))
    y = y_intra + y_inter + d_skip.reshape(SSD_GROUPS, R)[:, :, None] * xs
    y = y.reshape(Bsz, L, SSD_WIDTH) * jax.nn.silu(z)
    yg = y.reshape(Bsz, L, SSD_GROUPS, SSD_WIDTH // SSD_GROUPS)
    yg = yg * lax.rsqrt(jnp.mean(yg * yg, axis=-1, keepdims=True) + NORM_EPS)
    return yg.reshape(Bsz, L, SSD_WIDTH) * norm_w


def hgrn2_mixer(q_raw, f_raw, i_raw, g_raw, lb, norm_w):
    Bsz, L, _ = q_raw.shape
    nc = L // HG_CHUNK
    kshp = (Bsz, nc, HG_CHUNK, HG_HEADS, HG_KEY_HEAD)
    lbh = lb.reshape(HG_HEADS, HG_KEY_HEAD)
    a = f_raw.reshape(kshp)
    q = jax.nn.silu(q_raw).reshape(kshp)
    f = lbh + (1.0 - lbh) * jax.nn.sigmoid(a)
    logf = jnp.log(f)
    k = (1.0 - lbh) * jax.nn.sigmoid(-a)
    v = i_raw.reshape(Bsz, nc, HG_CHUNK, HG_HEADS, HG_VAL_HEAD)
    b = jnp.cumsum(logf, axis=2)
    b_last = b[:, :, -1:]
    b_ref = b[:, :, HG_CHUNK // 2 - 1:HG_CHUNK // 2]
    qe_rel = q * jnp.exp(b - b_ref)
    ke_rel = k * jnp.exp(b_ref - b)
    kd = k * jnp.exp(b_last - b)
    mask = jnp.tril(jnp.ones((HG_CHUNK, HG_CHUNK), dtype=bool))
    scores = jnp.einsum('bcthd,bcshd->bchts', qe_rel, ke_rel)
    scores = jnp.where(mask, scores, 0.0)
    o_intra = jnp.einsum('bchts,bcshv->bcthv', scores, v)
    contrib = jnp.einsum('bcshd,bcshv->bchdv', kd, v)
    decay = jnp.exp(b_last[:, :, 0])[..., None]
    s_prev = chunk_state_scan(decay, contrib)
    o_inter = jnp.einsum('bcthd,bchdv->bcthv', q * jnp.exp(b), s_prev)
    o = (o_intra + o_inter).reshape(Bsz, L, HG_HEADS, HG_VAL_HEAD)
    o = o * lax.rsqrt(jnp.mean(o * o, axis=-1, keepdims=True) + NORM_EPS) * norm_w
    o = o * jax.nn.silu(g_raw.reshape(Bsz, L, HG_HEADS, HG_VAL_HEAD))
    return o.reshape(Bsz, L, HG_WIDTH)


def setup_inputs(seed: int = 0) -> dict:
    key = jax.random.key(seed)
    ks = jax.random.split(key, 24)
    f32 = jnp.float32

    def nrm(k, shape, fan_in):
        return jax.random.normal(k, shape, f32) * (fan_in ** -0.5)

    def gain(k, shape):
        return 1.0 + 0.05 * jax.random.normal(k, shape, f32)

    u = jax.random.uniform(ks[11], (DEPTH, SSD_HEADS), f32)
    dt0 = jnp.exp(u * (jnp.log(0.1) - jnp.log(0.001)) + jnp.log(0.001))
    dt_bias = dt0 + jnp.log(-jnp.expm1(-dt0))
    return {
        "x": jax.random.normal(ks[0], (BATCH, SEQ, D_MODEL), f32),
        "ffn1_norm": gain(ks[1], (DEPTH, D_MODEL)),
        "ffn1_w_gate": nrm(ks[2], (DEPTH, D_MODEL, D_FF), D_MODEL),
        "ffn1_w_up": nrm(ks[3], (DEPTH, D_MODEL, D_FF), D_MODEL),
        "ffn1_w_down": nrm(ks[4], (DEPTH, D_FF, D_MODEL), D_FF),
        "mix_norm": gain(ks[5], (DEPTH, D_MODEL)),
        "w_in": nrm(ks[6], (DEPTH, D_MODEL, D_PROJ), D_MODEL),
        "ssd_conv_w": nrm(ks[7], (DEPTH, SSD_CONV, SSD_CONV_DIM), SSD_CONV),
        "ssd_conv_b": 0.02 * jax.random.normal(ks[8], (DEPTH, SSD_CONV_DIM), f32),
        "ssd_dt_bias": dt_bias,
        "ssd_a_log": jnp.log(jax.random.uniform(ks[9], (DEPTH, SSD_HEADS), f32, 1.0, 16.0)),
        "ssd_d": gain(ks[10], (DEPTH, SSD_HEADS)),
        "ssd_norm_w": gain(ks[12], (DEPTH, SSD_WIDTH)),
        "hg_lb_logits": 0.5 * jax.random.normal(ks[13], (DEPTH, HG_KEY_DIM), f32),
        "hg_norm_w": gain(ks[14], (DEPTH, HG_VAL_HEAD)),
        "w_out": nrm(ks[15], (DEPTH, D_MIX, D_MODEL), D_MIX),
        "ffn2_norm": gain(ks[16], (DEPTH, D_MODEL)),
        "ffn2_w_gate": nrm(ks[17], (DEPTH, D_MODEL, D_FF), D_MODEL),
        "ffn2_w_up": nrm(ks[18], (DEPTH, D_MODEL, D_FF), D_MODEL),
        "ffn2_w_down": nrm(ks[19], (DEPTH, D_FF, D_MODEL), D_FF),
        "final_norm": gain(ks[20], (D_MODEL,)),
    }


def reference(x, ffn1_norm, ffn1_w_gate, ffn1_w_up, ffn1_w_down, mix_norm, w_in,
              ssd_conv_w, ssd_conv_b, ssd_dt_bias, ssd_a_log, ssd_d, ssd_norm_w,
              hg_lb_logits, hg_norm_w, w_out, ffn2_norm, ffn2_w_gate, ffn2_w_up,
              ffn2_w_down, final_norm):
    f32 = jnp.float32
    lb_p = jax.nn.softmax(hg_lb_logits.astype(f32), axis=0)
    lower_bounds = jnp.cumsum(lb_p, axis=0) - lb_p[0]
    split_idx = list(np.cumsum([SSD_WIDTH, SSD_CONV_DIM, SSD_HEADS,
                                HG_KEY_DIM, HG_KEY_DIM, HG_WIDTH])[:])
    for l in range(DEPTH):
        x = x + 0.5 * swiglu(rmsnorm(x, ffn1_norm[l]), ffn1_w_gate[l], ffn1_w_up[l], ffn1_w_down[l])
        h = rmsnorm(x, mix_norm[l])
        proj = (h @ w_in[l]).astype(f32)
        z, xbc, dt_raw, q_raw, f_raw, i_raw, g_raw = jnp.split(proj, split_idx, axis=-1)
        y_ssd = ssd_mixer(z, xbc, dt_raw, ssd_conv_w[l].astype(f32), ssd_conv_b[l].astype(f32),
                          ssd_dt_bias[l].astype(f32), ssd_a_log[l].astype(f32),
                          ssd_d[l].astype(f32), ssd_norm_w[l].astype(f32))
        y_hg = hgrn2_mixer(q_raw, f_raw, i_raw, g_raw, lower_bounds[l], hg_norm_w[l].astype(f32))
        y = jnp.concatenate([y_ssd, y_hg], axis=-1).astype(x.dtype)
        x = x + y @ w_out[l]
        x = x + 0.5 * swiglu(rmsnorm(x, ffn2_norm[l]), ffn2_w_gate[l], ffn2_w_up[l], ffn2_w_down[l])
    return rmsnorm(x, final_norm)
```

```cpp
#include <hip/hip_runtime.h>
#include <hip/hip_cooperative_groups.h>
#include <cstdio>
#include <cstdint>
namespace cg = cooperative_groups;

namespace pg8 {
#define PG8_LAS __attribute__((address_space(3)))
typedef unsigned short bf16_t;
typedef short bf16x8 __attribute__((ext_vector_type(8)));
typedef float f32x4 __attribute__((ext_vector_type(4)));
typedef unsigned u32x4 __attribute__((ext_vector_type(4)));
constexpr int BM = 256, BK = 64, HALF = 128, HTB = HALF * BK * 2  , STAGE_BYTES = 8 * HTB, NXCD = 8, WGM = 8;

__host__ __device__ __forceinline__ int lds_byte(int r, int c) { const int st = (r >> 4) * 2 + (c >> 5), rr = r & 15, cc = c & 31, ob = rr * 64 + cc * 2; return st * 1024 + (ob ^ (((ob >> 9) & 1) << 5)); }
__host__ __device__ __forceinline__ void stage_rc(int b, int& R, int& C) { const int st = b / 1024, sb = b % 1024, swz = sb ^ (((sb >> 9) & 1) << 5); R = (st >> 1) * 16 + swz / 64; C = (st & 1) * 32 + (swz % 64) / 2; }
__host__ __device__ __forceinline__ int perm32(int rho) { const int n = rho >> 4, i = rho & 15; return 8 * (i >> 2) + 4 * n + (i & 3); }

struct Unit { int pm, pn; };
struct Gemm { const bf16_t* A; const bf16_t* Bt; int M, N, K; };

struct StaticOrder {
    int nM, nN, nwg, G, c;
    __host__ __device__ void init(int M, int N, int G_, int c_) { nM = M / BM; nN = N / BM; nwg = nM * nN; G = G_; c = c_; }
    __host__ __device__ bool next(int i, Unit& u) const {
        const long L = (long)i * G + c; if (L >= nwg) return false;
        int wgid = (int)L; const int xcd_ = wgid % NXCD; { const int q = nwg / NXCD, r = nwg % NXCD, xcd = wgid % NXCD, off = wgid / NXCD; wgid = (xcd < r ? xcd * (q + 1) : r * (q + 1) + (xcd - r) * q) + off; }
        const int nig = WGM * nN, gid = wgid / nig, fm = gid * WGM, gsz = (nM - fm) < WGM ? (nM - fm) : WGM;
        u.pm = fm + ((wgid % nig) % gsz); u.pn = ((wgid % nig) / gsz + (xcd_ * nN) / NXCD) % nN;
        return true;
    }
    __device__ __forceinline__ void a_ready(const Unit&) const {}
    __device__ __forceinline__ void done(const Unit&) const {}
};


typedef __bf16 bf16x2n __attribute__((ext_vector_type(2)));
typedef float f32x2n __attribute__((ext_vector_type(2)));
__device__ __forceinline__ unsigned pk2(float lo, float hi) { f32x2n v = {lo, hi}; bf16x2n b = __builtin_convertvector(v, bf16x2n); return __builtin_bit_cast(unsigned, b); }
__device__ __forceinline__ float silu_f(float x) { return x * __builtin_amdgcn_rcpf(1.0f + __expf(-x)); }

struct RevOrder : StaticOrder {
    __host__ __device__ bool next(int i, Unit& u) const { if (nwg % G != 0) return StaticOrder::next(i, u);
        const int nr = nwg / G; if (i >= nr) return false; return StaticOrder::next(nr - 1 - i, u); }
};
constexpr float RMS_EPS = 1e-6f;
__device__ __forceinline__ float row_rs(const float* ssq, unsigned row) {
    const f32x4* sp = (const f32x4*)(ssq + (size_t)row * 16); const f32x4 a = (sp[0] + sp[1]) + (sp[2] + sp[3]);
    return __builtin_amdgcn_rsqf(((a[0] + a[1]) + (a[2] + a[3])) * (1.0f / 1024.0f) + RMS_EPS);
}
#define PG8_RS8(ssq_, u_, row0_, rsv_, slot_, last_pm_) do { \
    if ((u_).pm != (last_pm_)) { _Pragma("unroll") for (int i_ = 0; i_ < 8; ++i_) (rsv_)[i_] = row_rs((ssq_), (row0_) + (i_ >> 2) * HALF + (i_ & 3) * 16); \
        *(PG8_LAS f32x4*)(slot_) = (f32x4){(rsv_)[0], (rsv_)[1], (rsv_)[2], (rsv_)[3]}; *(PG8_LAS f32x4*)((slot_) + 16) = (f32x4){(rsv_)[4], (rsv_)[5], (rsv_)[6], (rsv_)[7]}; (last_pm_) = (u_).pm; } \
    else { const f32x4 a_ = *(const PG8_LAS f32x4*)(slot_), b_ = *(const PG8_LAS f32x4*)((slot_) + 16); \
        (rsv_)[0] = a_[0]; (rsv_)[1] = a_[1]; (rsv_)[2] = a_[2]; (rsv_)[3] = a_[3]; (rsv_)[4] = b_[0]; (rsv_)[5] = b_[1]; (rsv_)[6] = b_[2]; (rsv_)[7] = b_[3]; } } while (0)
struct EpiGU {
    static constexpr bool PERM = true, AFTER_DRAIN = false;
    bf16_t* H; const float* ssq; int ldh; PG8_LAS unsigned char* slot; mutable int last_pm;
    __device__ __forceinline__ void operator()(const f32x4 (&acc)[2][2][4][2], const Unit& u, int wr, int wc, int fr, int fq) const {
        const int row0 = u.pm * BM + wr * 64 + fr, col0 = u.pn * HALF + wc * 32 + 8 * fq;
        float rsv[8]; PG8_RS8(ssq, u, row0, rsv, slot, last_pm);
#pragma unroll
        for (int ai = 0; ai < 2; ++ai)
#pragma unroll
            for (int m = 0; m < 4; ++m) { const int row = row0 + ai * HALF + m * 16; const float rs = rsv[ai * 4 + m];
                u32x4 w; unsigned wv[4];
#pragma unroll
                for (int n = 0; n < 2; ++n) { const f32x4 g = acc[ai][0][m][n] * rs, up = acc[ai][1][m][n] * rs;
                    const float h0 = silu_f(g[0]) * up[0], h1 = silu_f(g[1]) * up[1], h2 = silu_f(g[2]) * up[2], h3 = silu_f(g[3]) * up[3];
                    wv[2 * n] = pk2(h0, h1); wv[2 * n + 1] = pk2(h2, h3); }
                w.x = wv[0]; w.y = wv[1]; w.z = wv[2]; w.w = wv[3];
                *(u32x4*)(H + (size_t)row * ldh + col0) = w; }
    }
};
struct EpiRes {
    static constexpr bool PERM = true, AFTER_DRAIN = false;
    bf16_t* xb; float* ssq_out; float scale;
    __device__ __forceinline__ void operator()(const f32x4 (&acc)[2][2][4][2], const Unit& u, int wr, int wc, int fr, int fq) const {
        const unsigned row0 = u.pm * BM + wr * 64 + fr, col0 = u.pn * BM + wc * 32 + 8 * fq;
#pragma unroll
        for (int ai = 0; ai < 2; ++ai)
#pragma unroll
            for (int m = 0; m < 4; ++m) { const unsigned row = row0 + ai * HALF + m * 16; const unsigned off = row * 1024u + col0; float s = 0.f;
                const u32x4 bv0 = *(const u32x4*)(xb + off), bv1 = *(const u32x4*)(xb + off + HALF);
#pragma unroll
                for (int bj = 0; bj < 2; ++bj) { const u32x4 bv = bj ? bv1 : bv0;
                    const f32x4 b0 = {__uint_as_float(bv.x << 16), __uint_as_float(bv.x & 0xffff0000u), __uint_as_float(bv.y << 16), __uint_as_float(bv.y & 0xffff0000u)};
                    const f32x4 b1 = {__uint_as_float(bv.z << 16), __uint_as_float(bv.z & 0xffff0000u), __uint_as_float(bv.w << 16), __uint_as_float(bv.w & 0xffff0000u)};
                    const f32x4 v0 = b0 + acc[ai][bj][m][0] * scale, v1 = b1 + acc[ai][bj][m][1] * scale;
                    u32x4 w; w.x = pk2(v0[0], v0[1]); w.y = pk2(v0[2], v0[3]); w.z = pk2(v1[0], v1[1]); w.w = pk2(v1[2], v1[3]);
                    *(u32x4*)(xb + off + bj * HALF) = w;
                    s += (v0[0] * v0[0] + v0[1] * v0[1]) + (v0[2] * v0[2] + v0[3] * v0[3]) + (v1[0] * v1[0] + v1[1] * v1[1]) + (v1[2] * v1[2] + v1[3] * v1[3]); }
                s += __shfl_xor(s, 16); s += __shfl_xor(s, 32);
                if (fq == 0) ssq_out[(size_t)row * 16 + u.pn * 4 + wc] = s;
                asm volatile("" ::: "memory"); }
    }
};
struct EpiProj {
    static constexpr bool PERM = true, AFTER_DRAIN = false;
    bf16_t* P; const float* ssq; int ldp; PG8_LAS unsigned char* slot; const float* lb; mutable int last_pm;
    __device__ __forceinline__ void operator()(const f32x4 (&acc)[2][2][4][2], const Unit& u, int wr, int wc, int fr, int fq) const {
        const int row0 = u.pm * BM + wr * 64 + fr, col0 = u.pn * BM + wc * 32 + 8 * fq;
        float rsv[8]; PG8_RS8(ssq, u, row0, rsv, slot, last_pm);
        const bool fgate = (u.pn == 7) || (u.pn == 8);
        f32x4 lbv[2][2];
        if (fgate) {
#pragma unroll
            for (int bj = 0; bj < 2; ++bj) { lbv[bj][0] = *(const f32x4*)(lb + col0 - 1792 + bj * HALF); lbv[bj][1] = *(const f32x4*)(lb + col0 - 1792 + bj * HALF + 4); } }
        const bool act = (u.pn < 2) || (u.pn == 5) || (u.pn == 6) || (u.pn == 11) || (u.pn == 12);
#pragma unroll
        for (int ai = 0; ai < 2; ++ai)
#pragma unroll
            for (int m = 0; m < 4; ++m) { const int row = row0 + ai * HALF + m * 16; const float rs = rsv[ai * 4 + m];
                bf16_t* rowp = P + (size_t)row * ldp + col0;
#pragma unroll
                for (int bj = 0; bj < 2; ++bj) { f32x4 v0 = acc[ai][bj][m][0] * rs, v1 = acc[ai][bj][m][1] * rs;
                    if (act) {
#pragma unroll
                        for (int j = 0; j < 4; ++j) { v0[j] = silu_f(v0[j]); v1[j] = silu_f(v1[j]); } }
                    if (fgate) {
#pragma unroll
                        for (int j = 0; j < 4; ++j) {
                            const float e0 = fminf(__expf(-v0[j]), 1e30f), s0 = __builtin_amdgcn_rcpf(1.0f + e0), e1 = fminf(__expf(-v1[j]), 1e30f), s1 = __builtin_amdgcn_rcpf(1.0f + e1);
                            v0[j] = __logf(lbv[bj][0][j] + (1.0f - lbv[bj][0][j]) * s0); v1[j] = __logf(lbv[bj][1][j] + (1.0f - lbv[bj][1][j]) * s1); } }
                    u32x4 w; w.x = pk2(v0[0], v0[1]); w.y = pk2(v0[2], v0[3]); w.z = pk2(v1[0], v1[1]); w.w = pk2(v1[2], v1[3]);
                    *(u32x4*)(rowp + bj * HALF) = w; } }
    }
};

template <class Epi, class Sched, bool ALIGN_EPI = false, bool SP2 = false>
__device__ __forceinline__ void gemm_phase(PG8_LAS unsigned char* lds, const Gemm g, const Sched& S, const Epi& E) {
    int tid_l = threadIdx.x; asm volatile("" : "+v"(tid_l));
    const int tid = tid_l, wid = __builtin_amdgcn_readfirstlane(tid >> 6), lane = tid & 63, wr = wid >> 2, wc = wid & 3, fr = lane & 15, fq = lane >> 4;
    const int K = g.K, nt = K / BK;
    unsigned voffA[2], voffB[2];
#pragma unroll
    for (int i = 0; i < 2; ++i) { int R, C; stage_rc(tid * 16 + i * 8192, R, C); const int Rb = Epi::PERM ? ((R & ~31) + perm32(R & 31)) : R;
        voffA[i] = (unsigned)(R * K + C) * 2u; voffB[i] = (unsigned)(Rb * K + C) * 2u; }
    const size_t kstep = (size_t)(BK * 2);
    const size_t hstep = (size_t)HALF * K * 2;
    const size_t tstep = 2 * hstep;
    const unsigned ldsw = (unsigned)wid * 1024u;
    const int aoff = lds_byte(wr * 64 + fr, fq * 8), boff = lds_byte(wc * 32 + fr, fq * 8);
#define PG8_SA(b, h) (((b) * 2 + (h)) * HTB)
#define PG8_SB(b, h) ((4 + (b) * 2 + (h)) * HTB)
#define PG8_STAGE(bufoff, gbase, voff) do { _Pragma("unroll") for (int _i = 0; _i < 2; ++_i) \
        __builtin_amdgcn_global_load_lds((const unsigned*)((const char*)(gbase) + (voff)[_i]), (PG8_LAS unsigned*)(lds + (bufoff) + ldsw + _i * 8192), 16, 0, 0); } while (0)
#define PG8_LDA(dst, b, h) do { _Pragma("unroll") for (int m = 0; m < 4; ++m) _Pragma("unroll") for (int k = 0; k < 2; ++k) dst[m][k] = *(const PG8_LAS bf16x8*)(lds + PG8_SA(b, h) + aoff + m * 2048 + k * 1024); } while (0)
#define PG8_LDB(dst, b, h) do { _Pragma("unroll") for (int n = 0; n < 2; ++n) _Pragma("unroll") for (int k = 0; k < 2; ++k) dst[n][k] = *(const PG8_LAS bf16x8*)(lds + PG8_SB(b, h) + boff + n * 2048 + k * 1024); } while (0)
#define PG8_MMA(ai, bj, At, Bt) do { __builtin_amdgcn_s_setprio(1); _Pragma("unroll") for (int m = 0; m < 4; ++m) _Pragma("unroll") for (int n = 0; n < 2; ++n) _Pragma("unroll") for (int k = 0; k < 2; ++k) \
        acc[ai][bj][m][n] = __builtin_amdgcn_mfma_f32_16x16x32_bf16(Bt[n][k], At[m][k], acc[ai][bj][m][n], 0, 0, 0); __builtin_amdgcn_s_setprio(0); } while (0)
#define PG8_WAIT_V(n) asm volatile("s_waitcnt vmcnt(" #n ")" ::: "memory")
#define PG8_WAIT_L(n) asm volatile("s_waitcnt lgkmcnt(" #n ")" ::: "memory")
#define PG8_BAR __builtin_amdgcn_s_barrier()
#define PG8_SCHED __builtin_amdgcn_sched_barrier(0)
    Unit cur, nxt; int ui = 0;
    if (!S.next(0, cur)) return;
    f32x4 acc[2][2][4][2];
#pragma unroll
    for (int a = 0; a < 2; ++a)
#pragma unroll
        for (int b = 0; b < 2; ++b)
#pragma unroll
            for (int m = 0; m < 4; ++m)
#pragma unroll
                for (int n = 0; n < 2; ++n) acc[a][b][m][n] = (f32x4){0.f, 0.f, 0.f, 0.f};
    bf16x8 At[4][2], B0[2][2], B1[2][2];
    const char* cA = (const char*)g.A + (size_t)cur.pm * tstep; const char* cB = (const char*)g.Bt + (size_t)cur.pn * tstep;
    S.a_ready(cur);
    if constexpr (SP2) {
        PG8_STAGE(PG8_SB(0, 0), cB, voffB); PG8_STAGE(PG8_SB(0, 1), cB + hstep, voffB); PG8_STAGE(PG8_SA(0, 0), cA, voffA); PG8_STAGE(PG8_SA(0, 1), cA + hstep, voffA);
        if (wr == 1) PG8_BAR;
        PG8_WAIT_V(2); PG8_BAR;
        PG8_STAGE(PG8_SB(1, 0), cB + kstep, voffB); PG8_STAGE(PG8_SA(1, 0), cA + kstep, voffA); PG8_STAGE(PG8_SB(1, 1), cB + hstep + kstep, voffB);
        PG8_WAIT_V(6); PG8_BAR;
    } else {
        PG8_STAGE(PG8_SB(0, 0), cB, voffB); PG8_STAGE(PG8_SA(0, 0), cA, voffA); PG8_STAGE(PG8_SB(0, 1), cB + hstep, voffB); PG8_STAGE(PG8_SA(0, 1), cA + hstep, voffA);
        if (wr == 1) PG8_BAR;
        PG8_WAIT_V(4); PG8_BAR;
        PG8_STAGE(PG8_SB(1, 0), cB + kstep, voffB); PG8_STAGE(PG8_SA(1, 0), cA + kstep, voffA); PG8_STAGE(PG8_SB(1, 1), cB + hstep + kstep, voffB);
        PG8_WAIT_V(6); PG8_BAR;
    }
    for (;;) {
        const bool has_next = S.next(ui + 1, nxt);
        const char* nA = has_next ? (const char*)g.A + (size_t)nxt.pm * tstep : cA; const char* nB = has_next ? (const char*)g.Bt + (size_t)nxt.pn * tstep : cB;
        for (int t = 0; t < nt; t += 2) {
            const bool last = (t == nt - 2);
            const char* a1 = cA + (size_t)(t + 1) * kstep;
            const char* a2 = last ? nA : cA + (size_t)(t + 2) * kstep; const char* b2 = last ? nB : cB + (size_t)(t + 2) * kstep;
            const char* a3 = a2 + kstep; const char* b3 = b2 + kstep;
            if (last && has_next) S.a_ready(nxt);
            if constexpr (SP2) {
            PG8_LDB(B0, 0, 0); PG8_LDB(B1, 0, 1); PG8_SCHED; PG8_LDA(At, 0, 0); PG8_STAGE(PG8_SA(1, 1), a1 + hstep, voffA);
            PG8_WAIT_V(8); PG8_WAIT_L(0); PG8_BAR; PG8_MMA(0, 0, At, B0); PG8_MMA(0, 1, At, B1); PG8_BAR; PG8_SCHED;
            PG8_LDA(At, 0, 1); PG8_STAGE(PG8_SB(0, 0), b2, voffB); PG8_STAGE(PG8_SB(0, 1), b2 + hstep, voffB); PG8_STAGE(PG8_SA(0, 0), a2, voffA);
            PG8_WAIT_V(8); PG8_WAIT_L(0); PG8_BAR; PG8_MMA(1, 0, At, B0); PG8_MMA(1, 1, At, B1); PG8_BAR; PG8_SCHED;
            PG8_LDB(B0, 1, 0); PG8_LDB(B1, 1, 1); PG8_SCHED; PG8_LDA(At, 1, 0); PG8_STAGE(PG8_SA(0, 1), a2 + hstep, voffA);
            PG8_WAIT_V(8); PG8_WAIT_L(0); PG8_BAR; PG8_MMA(0, 0, At, B0); PG8_MMA(0, 1, At, B1); PG8_BAR; PG8_SCHED;
            PG8_LDA(At, 1, 1); PG8_STAGE(PG8_SB(1, 0), b3, voffB); PG8_STAGE(PG8_SB(1, 1), b3 + hstep, voffB); PG8_STAGE(PG8_SA(1, 0), a3, voffA);
            PG8_WAIT_V(8); PG8_WAIT_L(0); PG8_BAR; PG8_MMA(1, 0, At, B0); PG8_MMA(1, 1, At, B1); PG8_BAR; PG8_SCHED;
            } else {
            PG8_LDB(B0, 0, 0); PG8_SCHED; PG8_LDA(At, 0, 0); PG8_STAGE(PG8_SA(1, 1), a1 + hstep, voffA);
            PG8_WAIT_L(8); PG8_BAR; PG8_WAIT_L(0); PG8_MMA(0, 0, At, B0); PG8_BAR; PG8_SCHED;
            PG8_LDB(B1, 0, 1); PG8_STAGE(PG8_SB(0, 0), b2, voffB);
            PG8_BAR; PG8_WAIT_L(0); PG8_MMA(0, 1, At, B1); PG8_BAR;
            PG8_LDA(At, 0, 1); PG8_STAGE(PG8_SA(0, 0), a2, voffA);
            PG8_BAR; PG8_WAIT_L(0); PG8_MMA(1, 0, At, B0); PG8_BAR; PG8_SCHED;
            PG8_STAGE(PG8_SB(0, 1), b2 + hstep, voffB);
            PG8_WAIT_V(6); PG8_BAR; PG8_MMA(1, 1, At, B1); PG8_BAR;
            PG8_LDB(B0, 1, 0); PG8_SCHED; PG8_LDA(At, 1, 0); PG8_STAGE(PG8_SA(0, 1), a2 + hstep, voffA);
            PG8_WAIT_L(8); PG8_BAR; PG8_WAIT_L(0); PG8_MMA(0, 0, At, B0); PG8_BAR; PG8_SCHED;
            PG8_LDB(B1, 1, 1); PG8_STAGE(PG8_SB(1, 0), b3, voffB);
            PG8_BAR; PG8_WAIT_L(0); PG8_MMA(0, 1, At, B1); PG8_BAR;
            PG8_LDA(At, 1, 1); PG8_STAGE(PG8_SA(1, 0), a3, voffA);
            PG8_BAR; PG8_WAIT_L(0); PG8_MMA(1, 0, At, B0); PG8_BAR; PG8_SCHED;
            PG8_STAGE(PG8_SB(1, 1), b3 + hstep, voffB);
            PG8_WAIT_V(6); PG8_BAR; PG8_MMA(1, 1, At, B1); PG8_BAR;
            }
        }
        if constexpr (ALIGN_EPI) { if (wr == 0) PG8_BAR; }
        if constexpr (!Epi::AFTER_DRAIN) { E(acc, cur, wr, wc, fr, fq); S.done(cur); }
        if (!has_next) break;
#pragma unroll
        for (int a = 0; a < 2; ++a)
#pragma unroll
            for (int b = 0; b < 2; ++b)
#pragma unroll
                for (int m = 0; m < 4; ++m)
#pragma unroll
                    for (int n = 0; n < 2; ++n) acc[a][b][m][n] = (f32x4){0.f, 0.f, 0.f, 0.f};
        cur = nxt; cA = nA; cB = nB; ++ui;
        if constexpr (ALIGN_EPI) { if (wr == 1) PG8_BAR; }
    }
    PG8_WAIT_V(0);
    if constexpr (!ALIGN_EPI) { if (wr == 0) PG8_BAR; }
    PG8_BAR;
    if constexpr (Epi::AFTER_DRAIN) { E.fused(acc, cur, wr, wc, fr, fq, lds, wid, lane); S.done(cur); }
#undef PG8_SA
#undef PG8_SB
#undef PG8_STAGE
#undef PG8_LDA
#undef PG8_LDB
#undef PG8_MMA
#undef PG8_WAIT_V
#undef PG8_WAIT_L
#undef PG8_BAR
#undef PG8_SCHED
}
}

#define DI __device__ __forceinline__
#define LAS __attribute__((address_space(3)))
typedef unsigned short bf16_t;
typedef short bf16x8 __attribute__((ext_vector_type(8)));
typedef short s16x4 __attribute__((ext_vector_type(4)));
typedef float f32x4 __attribute__((ext_vector_type(4)));
typedef unsigned u32x4 __attribute__((ext_vector_type(4)));
typedef unsigned u32x2 __attribute__((ext_vector_type(2)));
using pg8::pk2; using pg8::silu_f;

constexpr int NWAVES = 8, NTHR = 512;
constexpr int M = 65536, D = 1024, FF = 2816, NGU = 2 * FF, PL = 3584, SEQ = 2048, DEPTH = 4, DPROJ = 3336;
constexpr int LDS_BYTES = 131072 + 256 + 16384, MISC_OFF = 131072, RSC_OFF = 131072 + 256;
constexpr size_t MiB = 1u << 20;
constexpr size_t WS_SSQ = 880 * MiB;
constexpr size_t WS_LB = 5 * MiB;
constexpr size_t WS_W = 8 * MiB;
constexpr size_t W_GU1 = 0, W_D1 = 11 * MiB, W_IN = W_D1 + 11 * MiB / 2, W_OUT = W_IN + 7 * MiB, W_GU2 = W_OUT + 2 * MiB, W_D2 = W_GU2 + 11 * MiB, W_LAYER = 42 * MiB;
static_assert(W_D2 + 11 * MiB / 2 == W_LAYER, "weight map");
constexpr size_t WS_XB = 176 * MiB;
constexpr size_t WS_Y = 304 * MiB;
constexpr size_t WS_R = 432 * MiB;
constexpr size_t WS_DTA = 932 * MiB;
constexpr size_t WS_EBV = 948 * MiB;
constexpr size_t WS_END = 956 * MiB;
static_assert(WS_W + 4 * W_LAYER == WS_XB && WS_R + (size_t)M * PL * 2 == WS_SSQ && WS_SSQ + 13 * 4 * MiB == WS_DTA, "ws map");

DI float bf2f(unsigned short h) { return __uint_as_float((unsigned)h << 16); }
DI float wave_sum(float v) {
#pragma unroll
    for (int o = 1; o < 64; o <<= 1) v += __shfl_xor(v, o);
    return v;
}
#define LDS_WAIT() asm volatile("s_waitcnt lgkmcnt(0)" ::: "memory")
DI f32x4 mma(bf16x8 a, bf16x8 b, f32x4 c) { return __builtin_amdgcn_mfma_f32_16x16x32_bf16(a, b, c, 0, 0, 0); }
DI bf16x8 pack8(f32x4 a, f32x4 b) { u32x4 w; w.x = pk2(a[0], a[1]); w.y = pk2(a[2], a[3]); w.z = pk2(b[0], b[1]); w.w = pk2(b[2], b[3]); return __builtin_bit_cast(bf16x8, w); }
constexpr int LS = 144;
DI bf16x8 ld_perm(const LAS unsigned char* base, int row, int kk, int q) {
    const LAS unsigned char* p = base + row * LS + kk * 64 + q * 8;
    const s16x4 lo = *(const LAS s16x4*)p, hi = *(const LAS s16x4*)(p + 32);
    return __builtin_shufflevector(lo, hi, 0, 1, 2, 3, 4, 5, 6, 7);
}
DI bf16x8 scale8(bf16x8 x, f32x4 wlo, f32x4 whi) {
    const u32x4 u = __builtin_bit_cast(u32x4, x);
    f32x4 a, b;
    a[0] = __uint_as_float(u.x << 16) * wlo[0]; a[1] = __uint_as_float(u.x & 0xffff0000u) * wlo[1];
    a[2] = __uint_as_float(u.y << 16) * wlo[2]; a[3] = __uint_as_float(u.y & 0xffff0000u) * wlo[3];
    b[0] = __uint_as_float(u.z << 16) * whi[0]; b[1] = __uint_as_float(u.z & 0xffff0000u) * whi[1];
    b[2] = __uint_as_float(u.w << 16) * whi[2]; b[3] = __uint_as_float(u.w & 0xffff0000u) * whi[3];
    return pack8(a, b);
}

#define XB_TMO      128
#define XB_XCNT(j)  (256  + 64 * (j))
#define XB_XSUB(j)  (1280 + 64 * (j))
#define XB_XGEN(j)  (2304 + 64 * (j))
#define XB_TOP      3328
#define XB_TOPGEN   3392
#define XCD_BAR_WORDS 3456
#define XB_SPIN_CAP (1u << 18)

__device__ __forceinline__ unsigned xb_ld(unsigned* p)              { return __hip_atomic_load(p, __ATOMIC_RELAXED, __HIP_MEMORY_SCOPE_AGENT); }
__device__ __forceinline__ unsigned xb_add(unsigned* p, unsigned v) { return __hip_atomic_fetch_add(p, v, __ATOMIC_RELAXED, __HIP_MEMORY_SCOPE_AGENT); }
__device__ __forceinline__ unsigned xb_xcc_id() { return (unsigned)__builtin_amdgcn_s_getreg((3 << 11) | 20) & 0xFu; }
#define XB_SPIN(cond, bar) do { unsigned _sp = 0; while (cond) { __builtin_amdgcn_s_sleep(1); \
    if ((++_sp & 255u) == 0u) { if (xb_ld(&(bar)[XB_TMO])) break; if (_sp > XB_SPIN_CAP) { atomicAdd(&(bar)[XB_TMO], 1u); break; } } } } while (0)

struct XcdBarrier {
    unsigned* bar; unsigned x;
    volatile LAS unsigned* st;
};

__device__ __forceinline__ XcdBarrier xcd_barrier_post(unsigned* bar, volatile LAS unsigned* st) {
    XcdBarrier b; b.bar = bar; b.x = xb_xcc_id(); b.st = st;
    if (threadIdx.x == 0) (void)xb_add(&bar[XB_XCNT(b.x)], 1u);
    return b;
}
__device__ __forceinline__ void xcd_barrier_complete(unsigned* bar, unsigned x, unsigned& nloc, unsigned& nx) {
    const unsigned G = gridDim.x * gridDim.y * gridDim.z;
    unsigned sum, cnt, mine, sp = 0u;
    for (;;) {
        sum = 0u; cnt = 0u; mine = 0u;
#pragma unroll
        for (unsigned j = 0; j < 16; ++j) { const unsigned c = xb_ld(&bar[XB_XCNT(j)]); sum += c; cnt += (c > 0u) ? 1u : 0u; mine = (j == x) ? c : mine; }
        if (sum == G) break;
        __builtin_amdgcn_s_sleep(1);
        if ((++sp & 255u) == 0u) { if (xb_ld(&bar[XB_TMO])) break; if (sp > XB_SPIN_CAP) { atomicAdd(&bar[XB_TMO], 1u); break; } }
    }
    nloc = mine > 0u ? mine : 1u; nx = cnt > 0u ? cnt : 1u;
}

__device__ __forceinline__ void xcd_barrier(const XcdBarrier& b) {
    asm volatile("s_waitcnt vmcnt(0)" ::: "memory");
    __syncthreads();
    if (threadIdx.x == 0) {
        unsigned* bar = b.bar;
        __builtin_amdgcn_s_waitcnt(0);
        unsigned nloc = b.st[0], nx = b.st[1];
        if (nloc == 0u) { xcd_barrier_complete(bar, b.x, nloc, nx); b.st[0] = nloc; b.st[1] = nx; }
        const unsigned old = xb_add(&bar[XB_XSUB(b.x)], 1u);
        const unsigned gen = old / nloc;
        if (old + 1u == (gen + 1u) * nloc) {
            __builtin_amdgcn_fence(__ATOMIC_RELEASE, "agent");
            asm volatile("s_waitcnt vmcnt(0)" ::: "memory");
            const unsigned og = xb_add(&bar[XB_TOP], 1u);
            const unsigned tg = og / nx;
            if (og + 1u == (tg + 1u) * nx) xb_add(&bar[XB_TOPGEN], 1u);
            else XB_SPIN(xb_ld(&bar[XB_TOPGEN]) == tg, bar);
            __builtin_amdgcn_fence(__ATOMIC_ACQUIRE, "agent");
            xb_add(&bar[XB_XGEN(b.x)], 1u);
            asm volatile("s_waitcnt vmcnt(0)" ::: "memory");
        } else {
            XB_SPIN(xb_ld(&bar[XB_XGEN(b.x)]) == gen, bar);
            __builtin_amdgcn_fence(__ATOMIC_ACQUIRE, "agent");
            asm volatile("s_waitcnt vmcnt(0)" ::: "memory");
        }
    }
    __syncthreads();
}

DI void p0_item(const float* W, int ldsrc, int k0, int src_col0, int nvalid, const float* normw, bf16_t* WT, int ldk, int dst_row0, LAS float* scr, int lane) {
    const int c = lane & 31;
#pragma unroll
    for (int i = 0; i < 32; ++i) { const int kk = 2 * i + (lane >> 5);
        float v = (c < nvalid) ? W[(size_t)(k0 + kk) * ldsrc + src_col0 + c] : 0.f;
        if (normw) v *= normw[k0 + kk];
        scr[kk * 33 + c] = v; }
    LDS_WAIT(); asm volatile("" ::: "memory");
    const int c8 = lane & 7;
#pragma unroll
    for (int j = 0; j < 4; ++j) { const int n = (lane >> 3) + 8 * j; const LAS float* s = scr + (8 * c8) * 33 + n;
        u32x4 o; o.x = pk2(s[0 * 33], s[1 * 33]); o.y = pk2(s[2 * 33], s[3 * 33]); o.z = pk2(s[4 * 33], s[5 * 33]); o.w = pk2(s[6 * 33], s[7 * 33]);
        *(u32x4*)(WT + (size_t)(dst_row0 + n) * ldk + k0 + 8 * c8) = o; }
    LDS_WAIT(); asm volatile("" ::: "memory");
}

struct Args { const float* in[21]; float* out; unsigned char* ws; };

DI void convert_layer(const Args& a, int l, LAS unsigned char* lds, int gw, int NGW, int lane_in, int wave) {
    int lane = lane_in; asm volatile("" : "+v"(lane));
    unsigned char* ws = a.ws;
    LAS float* scr = (LAS float*)(lds + wave * 16384);
    constexpr int I_GU = (NGU / 32) * (D / 64), I_D = (D / 32) * (FF / 64), I_IN = (PL / 32) * (D / 64), I_OUT = (D / 32) * (D / 64);
    constexpr int I_LAYER = 2 * I_GU + 2 * I_D + I_IN + I_OUT;
    unsigned char* wl = ws + WS_W + (size_t)l * W_LAYER;
    for (int it = gw; it < I_LAYER; it += NGW) {
        int r = it;
        int which = 0;
        if (r >= I_GU) { r -= I_GU; which = 1; if (r >= I_D) { r -= I_D; which = 2; if (r >= I_IN) { r -= I_IN; which = 3; if (r >= I_OUT) { r -= I_OUT; which = 4; if (r >= I_GU) { r -= I_GU; which = 5; } } } } }
        if (which == 0 || which == 4) {
            const int nblk = NGU / 32, kb = r / nblk, nb = r % nblk, pn = nb >> 3, j = nb & 7;
            const float* src = (j < 4) ? a.in[which == 0 ? 2 : 17] : a.in[which == 0 ? 3 : 18];
            const float* nw = a.in[which == 0 ? 1 : 16] + (size_t)l * D;
            p0_item(src + (size_t)l * D * FF, FF, 64 * kb, 128 * pn + 32 * (j & 3), 32, nw, (bf16_t*)(wl + (which == 0 ? W_GU1 : W_GU2)), D, 32 * nb, scr, lane);
        } else if (which == 1 || which == 5) {
            const int nblk = D / 32, kb = r / nblk, nb = r % nblk;
            p0_item(a.in[which == 1 ? 4 : 19] + (size_t)l * FF * D, D, 64 * kb, 32 * nb, 32, nullptr, (bf16_t*)(wl + (which == 1 ? W_D1 : W_D2)), FF, 32 * nb, scr, lane);
        } else if (which == 2) {
            const int nblk = PL / 32, kb = r / nblk, nb = r % nblk;
            int sc, nv;
            if (nb < 40) { sc = 32 * nb; nv = 32; } else if (nb < 104) { sc = 32 * nb + 8; nv = 32; } else if (nb == 104) { sc = 1280; nv = 8; } else { sc = 0; nv = 0; }
            p0_item(a.in[6] + (size_t)l * D * DPROJ, DPROJ, 64 * kb, sc, nv, a.in[5] + (size_t)l * D, (bf16_t*)(wl + W_IN), D, 32 * nb, scr, lane);
        } else {
            const int nblk = D / 32, kb = r / nblk, nb = r % nblk;
            p0_item(a.in[15] + (size_t)l * D * D, D, 64 * kb, 32 * nb, 32, nullptr, (bf16_t*)(wl + W_OUT), D, 32 * nb, scr, lane);
        }
    }
}

DI void prologue(const Args& a, LAS unsigned char* lds, int gw, int NGW, int lane, int wave) {
    unsigned char* ws = a.ws;
    if (blockIdx.x == 0) { const int c = threadIdx.x; const float* lg = a.in[13];
        const float x0 = lg[c], x1 = lg[512 + c], x2 = lg[1024 + c], x3 = lg[1536 + c]; const float mx = fmaxf(fmaxf(x0, x1), fmaxf(x2, x3));
        const float e0 = __expf(x0 - mx), e1 = __expf(x1 - mx), e2 = __expf(x2 - mx), e3 = __expf(x3 - mx); const float inv = 1.0f / (e0 + e1 + e2 + e3);
        float* LB = (float*)(ws + WS_LB); LB[c] = 0.f; LB[512 + c] = e1 * inv; LB[1024 + c] = (e1 + e2) * inv; LB[1536 + c] = (e1 + e2 + e3) * inv; }
    { const float* x = a.in[0]; bf16_t* XB = (bf16_t*)(ws + WS_XB); float* ssq0 = (float*)(ws + WS_SSQ);
      for (int m0 = gw; m0 < M; m0 += 2 * NGW) { f32x4 v[2][4];
#pragma unroll
          for (int h = 0; h < 2; ++h) { const int m = m0 + h * NGW; const f32x4* xr = (const f32x4*)(x + (size_t)m * D) + lane;
#pragma unroll
              for (int j = 0; j < 4; ++j) v[h][j] = xr[64 * j]; }
#pragma unroll
          for (int h = 0; h < 2; ++h) { const int m = m0 + h * NGW; float s = 0.f;
#pragma unroll
              for (int j = 0; j < 4; ++j) s += (v[h][j].x * v[h][j].x + v[h][j].y * v[h][j].y) + (v[h][j].z * v[h][j].z + v[h][j].w * v[h][j].w);
              s = wave_sum(s);
              u32x2* o8 = (u32x2*)(XB + (size_t)m * D) + lane;
#pragma unroll
              for (int j = 0; j < 4; ++j) { u32x2 w; w.x = pk2(v[h][j].x, v[h][j].y); w.y = pk2(v[h][j].z, v[h][j].w); o8[64 * j] = w; }
              if (lane < 16) ssq0[(size_t)m * 16 + lane] = (lane == 0) ? s : 0.f; } } }
    convert_layer(a, 0, lds, gw, NGW, lane, wave);
}

struct MixL { bf16_t* proj; bf16_t* Y; bf16_t* XA; float* DTA; float* EBV; const float *conv_w, *conv_b, *dt_bias, *a_log, *dskip, *ssd_nw, *lb, *hg_nw; };


constexpr int SSD_STG = 73728, SSD_DT2 = 122880;
DI void ssd_dma(LAS unsigned char* lds, const MixL& P, size_t rowbase, int b, int g, int c, int tid, int wave) {
    const int t0 = c * 64;
    { const int cgi = tid & 31, run = tid >> 5;
      const int c0 = 256 * g + 8 * cgi;
#pragma unroll
      for (int j = 0; j < 4; ++j) __builtin_amdgcn_global_load_lds((const unsigned*)(P.XA + (rowbase + t0 + 4 * run + j) * 768 + c0), (LAS unsigned*)(lds + SSD_STG + j * 8192 + wave * 1024), 16, 0, 0); }
    if (wave < 4) { const int run = (tid & 127) >> 3;
      const int c0 = (wave < 2 ? 512 : 640) + 64 * g + 8 * (tid & 7);
#pragma unroll
      for (int j = 0; j < 4; ++j) __builtin_amdgcn_global_load_lds((const unsigned*)(P.XA + (rowbase + t0 + 4 * run + j) * 768 + c0), (LAS unsigned*)(lds + SSD_STG + 32768 + j * 4096 + wave * 1024), 16, 0, 0);
      __builtin_amdgcn_global_load_lds((const unsigned*)(P.DTA + (size_t)(b * 32 + c) * 2048 + wave * 512 + (4 * g + ((tid & 63) >> 4)) * 64 + 4 * (tid & 15)), (LAS unsigned*)(lds + SSD_DT2 + wave * 1024), 16, 0, 0); }
}
DI void ssd_unit(LAS unsigned char* lds, const MixL& P, int b, int g) {
    int tid_l = threadIdx.x; asm volatile("" : "+v"(tid_l));
    const int tid = tid_l, lane = tid & 63, wave = __builtin_amdgcn_readfirstlane(tid >> 6), l15 = lane & 15, q = lane >> 4;
    const int r = wave >> 1, hh = wave & 1;
    LAS unsigned char* XT = lds; LAS unsigned char* BMp = lds + 36864; LAS unsigned char* BTp = lds + 46080; LAS unsigned char* CMp = lds + 55296;
    LAS float* ACUM = (LAS float*)(lds + 64512); LAS float* DTV = ACUM + 256; LAS float* EA = ACUM + 512; LAS float* WV = ACUM + 768; LAS float* SSQP = ACUM + 1024;
    const float Dr = P.dskip[4 * g + r];
    const size_t rowbase = (size_t)b * SEQ;
    const int ycol = 256 * g + 64 * r + 32 * hh + 4 * q;
    const LAS unsigned char* XTr = XT + r * 64 * LS;
    const LAS float* ac = ACUM + r * 64; const LAS float* dtv = DTV + r * 64; const LAS float* ea = EA + r * 64; const LAS float* wv = WV + r * 64;
    f32x4 ST[4][2];
#pragma unroll
    for (int i = 0; i < 4; ++i)
#pragma unroll
        for (int j = 0; j < 2; ++j) ST[i][j] = (f32x4){0.f, 0.f, 0.f, 0.f};
    f32x4 nwv[2];
#pragma unroll
    for (int pt = 0; pt < 2; ++pt) nwv[pt] = *(const f32x4*)(P.ssd_nw + ycol + 16 * pt);
    ssd_dma(lds, P, rowbase, b, g, 0, tid, wave);
#pragma unroll 1
    for (int c = 0; c < SEQ / 64; ++c) {
        const int t0 = c * 64;
        asm volatile("s_waitcnt vmcnt(0)" ::: "memory");
#pragma unroll
        for (int pass = 0; pass < 2; ++pass) {
            if (pass == 0 || wave < 4) {
            const int cgi = pass ? (wave < 2 ? 32 : 40) + (tid & 7) : (tid & 31), run = pass ? ((tid & 127) >> 3) : (tid >> 5);
            u32x4 rv[4];
#pragma unroll
            for (int j = 0; j < 4; ++j) rv[j] = *(const LAS u32x4*)(lds + SSD_STG + (pass ? 32768 + j * 4096 : j * 8192) + tid * 16);
            u32x2 tv[8];
#pragma unroll
            for (int e = 0; e < 8; ++e) { const unsigned a0 = rv[0][e >> 1], a1 = rv[1][e >> 1], a2 = rv[2][e >> 1], a3 = rv[3][e >> 1];
                if (e & 1) { tv[e].x = (a0 >> 16) | (a1 & 0xffff0000u); tv[e].y = (a2 >> 16) | (a3 & 0xffff0000u); }
                else { tv[e].x = (a0 & 0xffffu) | (a1 << 16); tv[e].y = (a2 & 0xffffu) | (a3 << 16); } }
            if (cgi < 32) { const int rr = cgi >> 3, p0 = 8 * (cgi & 7);
#pragma unroll
                for (int e = 0; e < 8; ++e) *(LAS u32x2*)(XT + (rr * 64 + p0 + e) * LS + ((run ^ ((cgi & 1) | (((cgi >> 2) & 7) << 1))) << 3)) = tv[e];
            } else if (cgi < 40) { const int n0 = 8 * (cgi - 32);
#pragma unroll
                for (int j = 0; j < 4; ++j) *(LAS u32x4*)(BMp + (4 * run + j) * LS + n0 * 2) = rv[j];
#pragma unroll
                for (int e = 0; e < 8; ++e) *(LAS u32x2*)(BTp + (n0 + e) * LS + run * 8) = tv[e];
            } else { const int n0 = 8 * (cgi - 40);
#pragma unroll
                for (int j = 0; j < 4; ++j) *(LAS u32x4*)(CMp + (4 * run + j) * LS + n0 * 2) = rv[j];
            }
            }
        }
        if (wave < 4) *(LAS u32x4*)(ACUM + 4 * tid) = *(const LAS u32x4*)(lds + SSD_DT2 + tid * 16);
        __syncthreads();
        u32x2 zr[2][4];
#pragma unroll
        for (int pt = 0; pt < 2; ++pt)
#pragma unroll
            for (int ti = 0; ti < 4; ++ti) zr[pt][ti] = *(const u32x2*)(P.proj + (rowbase + t0 + 16 * ti + l15) * PL + ycol + 16 * pt);
        if (c + 1 < SEQ / 64) ssd_dma(lds, P, rowbase, b, g, c + 1, tid, wave);
        bf16x8 bmp[4][2], cmp[4][2], xtp[2][2];
#pragma unroll
        for (int i = 0; i < 4; ++i)
#pragma unroll
            for (int kk = 0; kk < 2; ++kk) { bmp[i][kk] = ld_perm(BMp, 16 * i + l15, kk, q); cmp[i][kk] = ld_perm(CMp, 16 * i + l15, kk, q); }
#pragma unroll
        for (int pt = 0; pt < 2; ++pt)
#pragma unroll
            for (int kk = 0; kk < 2; ++kk) { const int gsw = (l15 >> 3) | (hh << 1) | (r << 2);
                const LAS unsigned char* pr_ = XTr + (32 * hh + 16 * pt + l15) * LS;
                const s16x4 lo_ = *(const LAS s16x4*)(pr_ + (((kk * 8 + q) ^ gsw) << 3)), hi_ = *(const LAS s16x4*)(pr_ + (((kk * 8 + q + 4) ^ gsw) << 3));
                xtp[pt][kk] = __builtin_shufflevector(lo_, hi_, 0, 1, 2, 3, 4, 5, 6, 7); }
        float at[4], eat[4]; f32x4 as4[4], ds4[4];
#pragma unroll
        for (int i = 0; i < 4; ++i) { at[i] = ac[16 * i + l15]; eat[i] = ea[16 * i + l15]; as4[i] = *(const LAS f32x4*)(ac + 16 * i + 4 * q); ds4[i] = *(const LAS f32x4*)(dtv + 16 * i + 4 * q); }
        const float eaend = ea[63];
        f32x4 y[2][4];
#pragma unroll
        for (int ti = 0; ti < 4; ++ti) {
            f32x4 lt[4];
#pragma unroll
            for (int sj = 0; sj < 4; ++sj) {
                if (sj <= ti) {
                    f32x4 ga = (f32x4){0.f, 0.f, 0.f, 0.f};
                    ga = mma(bmp[sj][0], cmp[ti][0], ga); ga = mma(bmp[sj][1], cmp[ti][1], ga);
#pragma unroll
                    for (int rr = 0; rr < 4; ++rr) { float v = ga[rr] * __expf(at[ti] - as4[sj][rr]) * ds4[sj][rr];
                        if (sj == ti) { const int sl = 4 * q + rr; v = (sl <= l15) ? v : 0.f; v = (sl == l15) ? v + Dr : v; }
                        lt[sj][rr] = v; }
                } else lt[sj] = (f32x4){0.f, 0.f, 0.f, 0.f};
            }
            const bf16x8 lf0 = pack8(lt[0], lt[1]), lf1 = pack8(lt[2], lt[3]);
#pragma unroll
            for (int pt = 0; pt < 2; ++pt) { f32x4 a = (f32x4){0.f, 0.f, 0.f, 0.f}; a = mma(xtp[pt][0], lf0, a); if (ti >= 2) a = mma(xtp[pt][1], lf1, a); y[pt][ti] = a; }
        }
#pragma unroll
        for (int pt = 0; pt < 2; ++pt) { const bf16x8 sf0 = pack8(ST[0][pt], ST[1][pt]), sf1 = pack8(ST[2][pt], ST[3][pt]);
#pragma unroll
            for (int ti = 0; ti < 4; ++ti) { f32x4 a = (f32x4){0.f, 0.f, 0.f, 0.f}; a = mma(sf0, cmp[ti][0], a); a = mma(sf1, cmp[ti][1], a); y[pt][ti] += a * eat[ti]; } }
        { bf16x8 xw[2][2];
#pragma unroll
          for (int kk = 0; kk < 2; ++kk) { const f32x4 wlo = *(const LAS f32x4*)(wv + 32 * kk + 4 * q), whi = *(const LAS f32x4*)(wv + 32 * kk + 16 + 4 * q);
#pragma unroll
              for (int pt = 0; pt < 2; ++pt) xw[pt][kk] = scale8(xtp[pt][kk], wlo, whi); }
#pragma unroll
          for (int nj = 0; nj < 4; ++nj) { const bf16x8 b0 = ld_perm(BTp, 16 * nj + l15, 0, q), b1 = ld_perm(BTp, 16 * nj + l15, 1, q);
#pragma unroll
              for (int pt = 0; pt < 2; ++pt) { f32x4 a = ST[nj][pt] * eaend; a = mma(b0, xw[pt][0], a); a = mma(b1, xw[pt][1], a); ST[nj][pt] = a; } } }
        float sq[4] = {0.f, 0.f, 0.f, 0.f};
#pragma unroll
        for (int pt = 0; pt < 2; ++pt)
#pragma unroll
            for (int ti = 0; ti < 4; ++ti) { const u32x2 zz = zr[pt][ti];
                const float z0 = __uint_as_float(zz.x << 16), z1 = __uint_as_float(zz.x & 0xffff0000u), z2 = __uint_as_float(zz.y << 16), z3 = __uint_as_float(zz.y & 0xffff0000u);
                f32x4 v = y[pt][ti]; v[0] *= z0; v[1] *= z1; v[2] *= z2; v[3] *= z3; y[pt][ti] = v;
                sq[ti] += (v[0] * v[0] + v[1] * v[1]) + (v[2] * v[2] + v[3] * v[3]); }
#pragma unroll
        for (int ti = 0; ti < 4; ++ti) { float s = sq[ti]; s += __shfl_xor(s, 16); s += __shfl_xor(s, 32); if (q == 0) SSQP[wave * 64 + 16 * ti + l15] = s; }
        __syncthreads();
#pragma unroll
        for (int ti = 0; ti < 4; ++ti) { float tot = 0.f;
#pragma unroll
            for (int w8 = 0; w8 < 8; ++w8) tot += SSQP[w8 * 64 + 16 * ti + l15];
            const float rs = __builtin_amdgcn_rsqf(tot * (1.0f / 256.0f) + pg8::RMS_EPS);
#pragma unroll
            for (int pt = 0; pt < 2; ++pt) { const f32x4 o = y[pt][ti] * rs * nwv[pt];
                u32x2 w2; w2.x = pk2(o[0], o[1]); w2.y = pk2(o[2], o[3]);
                *(u32x2*)(P.Y + (rowbase + t0 + 16 * ti + l15) * D + ycol + 16 * pt) = w2; } }
    }
}


constexpr int HG_STG = 81920;
DI void hg_dma(LAS unsigned char* lds, const MixL& P, size_t rowbase, int h, int c, int tid, int wave) {
    const int tc = tid & 255, cg = tc & 7, tp = tc >> 3;
    const bf16_t* pr = P.proj + (rowbase + c * 64 + 2 * tp) * PL + 64 * h + 8 * cg;
    __builtin_amdgcn_global_load_lds((const unsigned*)(pr + 1280), (LAS unsigned*)(lds + HG_STG + 0 * 8192 + wave * 1024), 16, 0, 0);
    __builtin_amdgcn_global_load_lds((const unsigned*)(pr + PL + 1280), (LAS unsigned*)(lds + HG_STG + 1 * 8192 + wave * 1024), 16, 0, 0);
    __builtin_amdgcn_global_load_lds((const unsigned*)(pr + 1792), (LAS unsigned*)(lds + HG_STG + 2 * 8192 + wave * 1024), 16, 0, 0);
    __builtin_amdgcn_global_load_lds((const unsigned*)(pr + PL + 1792), (LAS unsigned*)(lds + HG_STG + 3 * 8192 + wave * 1024), 16, 0, 0);
    __builtin_amdgcn_global_load_lds((const unsigned*)(pr + 2304), (LAS unsigned*)(lds + HG_STG + 4 * 8192 + wave * 1024), 16, 0, 0);
    __builtin_amdgcn_global_load_lds((const unsigned*)(pr + PL + 2304), (LAS unsigned*)(lds + HG_STG + 5 * 8192 + wave * 1024), 16, 0, 0);
}
DI void hg_unit(LAS unsigned char* lds, const MixL& P, int pi) {
    int tid_l = threadIdx.x; asm volatile("" : "+v"(tid_l));
    const int tid = tid_l, lane = tid & 63, wave = __builtin_amdgcn_readfirstlane(tid >> 6), l15 = lane & 15, q = lane >> 4;
    const int chain = wave >> 2, wv = wave & 3, ci = 2 * pi + chain, b = ci >> 3, h = ci & 7;
    LAS unsigned char* base = lds + chain * 40960;
    LAS unsigned char* QE = base; LAS unsigned char* KE = base + 9216; LAS unsigned char* KET = base + 18432; LAS unsigned char* VT = base + 27648;
    LAS float* EBREF = (LAS float*)(base + 36864); LAS float* EBLR = EBREF + 64; LAS float* EBLAST = EBREF + 128; LAS float* CUMQ = EBREF + 192; LAS float* SSQP = EBREF + 448;
    const int d = lane, tq = wv;
    const size_t rowbase = (size_t)b * SEQ;
    const int ycol = 64 * h + 16 * wv + 4 * q;
    f32x4 SD[4];
#pragma unroll
    for (int i = 0; i < 4; ++i) SD[i] = (f32x4){0.f, 0.f, 0.f, 0.f};
    const f32x4 nw = *(const f32x4*)(P.hg_nw + 16 * wv + 4 * q);
    hg_dma(lds, P, rowbase, h, 0, tid, wave);
#pragma unroll 1
    for (int c = 0; c < SEQ / 64; ++c) {
        const int t0 = c * 64;
        asm volatile("s_waitcnt vmcnt(0)" ::: "memory"); __syncthreads();
        float qv[16], kv[16], cs[16]; unsigned vv[8]; float runs = 0.f;
#pragma unroll
        for (int i = 0; i < 16; ++i) { const LAS unsigned char* sp = lds + HG_STG + (i & 1) * 8192 + (chain * 256 + (8 * tq + (i >> 1)) * 8 + (d >> 3)) * 16 + (d & 7) * 2;
            const float a = bf2f(*(const LAS unsigned short*)(sp + 2 * 8192)), qr = bf2f(*(const LAS unsigned short*)sp); const unsigned vb = *(const LAS unsigned short*)(sp + 4 * 8192);
            if (i & 1) vv[i >> 1] |= vb << 16; else vv[i >> 1] = vb;
            runs += a; cs[i] = runs; qv[i] = qr; kv[i] = 1.0f - __expf(a); }
        CUMQ[tq * 64 + d] = runs;
        __syncthreads();
        { const float c0 = CUMQ[d], c1 = CUMQ[64 + d], c2 = CUMQ[128 + d], c3 = CUMQ[192 + d];
          const float bref = c0 + c1, blast = bref + (c2 + c3);
          const float pre = (tq == 0) ? 0.f : (tq == 1 ? c0 : (tq == 2 ? bref : bref + c2));
          unsigned kt[8];
#pragma unroll
          for (int i = 0; i < 16; i += 2) { const float b0 = pre + cs[i], b1 = pre + cs[i + 1];
              const unsigned qp = pk2(qv[i] * __expf(b0 - bref), qv[i + 1] * __expf(b1 - bref)), kp = pk2(kv[i] * __expf(bref - b0), kv[i + 1] * __expf(bref - b1));
              *(LAS unsigned short*)(QE + (16 * tq + i) * LS + d * 2) = (unsigned short)(qp & 0xffffu); *(LAS unsigned short*)(QE + (16 * tq + i + 1) * LS + d * 2) = (unsigned short)(qp >> 16);
              *(LAS unsigned short*)(KE + (16 * tq + i) * LS + d * 2) = (unsigned short)(kp & 0xffffu); *(LAS unsigned short*)(KE + (16 * tq + i + 1) * LS + d * 2) = (unsigned short)(kp >> 16);
              kt[i >> 1] = kp; }
          *(LAS u32x4*)(KET + d * LS + tq * 32) = (u32x4){kt[0], kt[1], kt[2], kt[3]}; *(LAS u32x4*)(KET + d * LS + tq * 32 + 16) = (u32x4){kt[4], kt[5], kt[6], kt[7]};
          *(LAS u32x4*)(VT + d * LS + tq * 32) = (u32x4){vv[0], vv[1], vv[2], vv[3]}; *(LAS u32x4*)(VT + d * LS + tq * 32 + 16) = (u32x4){vv[4], vv[5], vv[6], vv[7]};
          if (tq == 0) { EBREF[d] = __expf(bref); EBLR[d] = __expf(blast - bref); EBLAST[d] = __expf(blast); } }
        __syncthreads();
        u32x2 gr[4];
#pragma unroll
        for (int ti = 0; ti < 4; ++ti) gr[ti] = *(const u32x2*)(P.proj + (rowbase + t0 + 16 * ti + l15) * PL + 2816 + ycol);
        if (c + 1 < SEQ / 64) hg_dma(lds, P, rowbase, h, c + 1, tid, wave);
        bf16x8 kep[4][2], qep[4][2], vtp[2];
#pragma unroll
        for (int i = 0; i < 4; ++i)
#pragma unroll
            for (int kk = 0; kk < 2; ++kk) { kep[i][kk] = ld_perm(KE, 16 * i + l15, kk, q); qep[i][kk] = ld_perm(QE, 16 * i + l15, kk, q); }
#pragma unroll
        for (int kk = 0; kk < 2; ++kk) vtp[kk] = ld_perm(VT, 16 * wv + l15, kk, q);
        f32x4 o[4];
#pragma unroll
        for (int ti = 0; ti < 4; ++ti) {
            f32x4 pt_[4];
#pragma unroll
            for (int sj = 0; sj < 4; ++sj) {
                if (sj <= ti) { f32x4 a = (f32x4){0.f, 0.f, 0.f, 0.f}; a = mma(kep[sj][0], qep[ti][0], a); a = mma(kep[sj][1], qep[ti][1], a);
                    if (sj == ti) {
#pragma unroll
                        for (int rr = 0; rr < 4; ++rr) a[rr] = (4 * q + rr <= l15) ? a[rr] : 0.f; }
                    pt_[sj] = a;
                } else pt_[sj] = (f32x4){0.f, 0.f, 0.f, 0.f};
            }
            const bf16x8 pf0 = pack8(pt_[0], pt_[1]), pf1 = pack8(pt_[2], pt_[3]);
            f32x4 a = (f32x4){0.f, 0.f, 0.f, 0.f}; a = mma(vtp[0], pf0, a); if (ti >= 2) a = mma(vtp[1], pf1, a); o[ti] = a;
        }
        { f32x4 er[4];
#pragma unroll
          for (int dj = 0; dj < 4; ++dj) er[dj] = *(const LAS f32x4*)(EBREF + 16 * dj + 4 * q);
          const bf16x8 sf0 = pack8(SD[0] * er[0], SD[1] * er[1]), sf1 = pack8(SD[2] * er[2], SD[3] * er[3]);
#pragma unroll
          for (int ti = 0; ti < 4; ++ti) { o[ti] = mma(sf0, qep[ti][0], o[ti]); o[ti] = mma(sf1, qep[ti][1], o[ti]); } }
#pragma unroll
        for (int dj = 0; dj < 4; ++dj) { f32x4 a = (f32x4){0.f, 0.f, 0.f, 0.f};
            a = mma(ld_perm(KET, 16 * dj + l15, 0, q), vtp[0], a); a = mma(ld_perm(KET, 16 * dj + l15, 1, q), vtp[1], a);
            const f32x4 el = *(const LAS f32x4*)(EBLAST + 16 * dj + 4 * q), elr = *(const LAS f32x4*)(EBLR + 16 * dj + 4 * q);
            SD[dj] = SD[dj] * el + a * elr; }
#pragma unroll
        for (int ti = 0; ti < 4; ++ti) { const f32x4 v = o[ti]; float s = (v[0] * v[0] + v[1] * v[1]) + (v[2] * v[2] + v[3] * v[3]); s += __shfl_xor(s, 16); s += __shfl_xor(s, 32);
            if (q == 0) SSQP[wv * 64 + 16 * ti + l15] = s; }
        __syncthreads();
#pragma unroll
        for (int ti = 0; ti < 4; ++ti) { const float tot = (SSQP[16 * ti + l15] + SSQP[64 + 16 * ti + l15]) + (SSQP[128 + 16 * ti + l15] + SSQP[192 + 16 * ti + l15]);
            const float rs = __builtin_amdgcn_rsqf(tot * (1.0f / 64.0f) + pg8::RMS_EPS); const u32x2 gg = gr[ti];
            const float g0 = __uint_as_float(gg.x << 16), g1 = __uint_as_float(gg.x & 0xffff0000u), g2 = __uint_as_float(gg.y << 16), g3 = __uint_as_float(gg.y & 0xffff0000u);
            f32x4 ov = o[ti] * rs * nw; ov[0] *= g0; ov[1] *= g1; ov[2] *= g2; ov[3] *= g3;
            u32x2 w2; w2.x = pk2(ov[0], ov[1]); w2.y = pk2(ov[2], ov[3]);
            *(u32x2*)(P.Y + (rowbase + t0 + 16 * ti + l15) * D + 512 + ycol) = w2; }
    }
}


DI void prep_ssd(const MixL& P, int b, int c) {
    int tid_l = threadIdx.x; asm volatile("" : "+v"(tid_l));
    const int tid = tid_l, lane = tid & 63, wave = __builtin_amdgcn_readfirstlane(tid >> 6);
    const size_t rowbase = (size_t)b * SEQ; const int t0 = c * 64;
    if (tid < 480) {
        const int cgi = tid % 96, r5 = tid / 96, c0 = 8 * cgi;
        float w[4][8], bias[8];
#pragma unroll
        for (int k = 0; k < 4; ++k) { const f32x4 w0 = *(const f32x4*)(P.conv_w + k * 768 + c0), w1 = *(const f32x4*)(P.conv_w + k * 768 + c0 + 4);
            w[k][0] = w0[0]; w[k][1] = w0[1]; w[k][2] = w0[2]; w[k][3] = w0[3]; w[k][4] = w1[0]; w[k][5] = w1[1]; w[k][6] = w1[2]; w[k][7] = w1[3]; }
        { const f32x4 b0 = *(const f32x4*)(P.conv_b + c0), b1 = *(const f32x4*)(P.conv_b + c0 + 4);
          bias[0] = b0[0]; bias[1] = b0[1]; bias[2] = b0[2]; bias[3] = b0[3]; bias[4] = b1[0]; bias[5] = b1[1]; bias[6] = b1[2]; bias[7] = b1[3]; }
        const bf16_t* src = P.proj + rowbase * PL + 512 + c0;
        u32x4 nxt[7];
#pragma unroll
        for (int i = 0; i < 7; ++i) { const int tok = t0 + 4 * r5 - 3 + i; nxt[i] = (tok >= 0) ? *(const u32x4*)(src + (size_t)tok * PL) : (u32x4){0u, 0u, 0u, 0u}; }
#pragma unroll 1
        for (int run = r5; run < 16; run += 5) {
            u32x4 raw[7];
#pragma unroll
            for (int i = 0; i < 7; ++i) raw[i] = nxt[i];
            if (run + 5 < 16) {
#pragma unroll
                for (int i = 0; i < 7; ++i) nxt[i] = *(const u32x4*)(src + (size_t)(t0 + 4 * (run + 5) - 3 + i) * PL); }
            u32x4 rv[4];
#pragma unroll
            for (int jp = 0; jp < 2; ++jp) {
                float v0[8], v1[8];
#pragma unroll
                for (int e = 0; e < 8; ++e) { float a0 = bias[e], a1 = bias[e];
#pragma unroll
                    for (int k = 0; k < 4; ++k) {
                        const unsigned d0 = raw[2 * jp + k][e >> 1], d1 = raw[2 * jp + 1 + k][e >> 1];
                        const float f0 = (e & 1) ? __uint_as_float(d0 & 0xffff0000u) : __uint_as_float(d0 << 16);
                        const float f1 = (e & 1) ? __uint_as_float(d1 & 0xffff0000u) : __uint_as_float(d1 << 16);
                        a0 += w[k][e] * f0; a1 += w[k][e] * f1; }
                    v0[e] = silu_f(a0); v1[e] = silu_f(a1); }
#pragma unroll
                for (int e2 = 0; e2 < 4; ++e2) { rv[2 * jp][e2] = pk2(v0[2 * e2], v0[2 * e2 + 1]); rv[2 * jp + 1][e2] = pk2(v1[2 * e2], v1[2 * e2 + 1]); }
            }
#pragma unroll
            for (int j = 0; j < 4; ++j) *(u32x4*)(P.XA + (rowbase + t0 + 4 * run + j) * 768 + c0) = rv[j];
        }
    }
    {
        float* dta = P.DTA + (size_t)(b * 32 + c) * 2048; const int hd = wave;
        const float x = bf2f(P.proj[(rowbase + t0 + lane) * PL + 3328 + hd]) + P.dt_bias[hd];
        const float dt = (x > 20.f) ? x : log1pf(__expf(x));
        float a = dt * (-__expf(P.a_log[hd]));
#pragma unroll
        for (int o = 1; o < 64; o <<= 1) { const float v = __shfl_up(a, o); if (lane >= o) a += v; }
        const float aend = __shfl(a, 63);
        dta[hd * 64 + lane] = a; dta[512 + hd * 64 + lane] = dt; dta[1024 + hd * 64 + lane] = __expf(a); dta[1536 + hd * 64 + lane] = dt * __expf(aend - a);
    }
}

__global__ void __launch_bounds__(NTHR, 2) hymba_fwd(Args a) {
    extern __shared__ __attribute__((aligned(16))) unsigned char lds_raw[];
    LAS unsigned char* lds = (LAS unsigned char*)lds_raw;
    cg::grid_group grid = cg::this_grid();
#define GSYNC0() do { asm volatile("s_waitcnt vmcnt(0) lgkmcnt(0)" ::: "memory"); grid.sync(); __builtin_amdgcn_fence(__ATOMIC_ACQUIRE, "agent"); asm volatile("s_waitcnt vmcnt(0)" ::: "memory"); } while (0)
#define GSYNC() do { XcdBarrier b_; b_.bar = (unsigned*)a.ws; b_.x = xb_xcc_id(); b_.st = (volatile LAS unsigned*)(lds + MISC_OFF) + 8; xcd_barrier(b_); } while (0)
    const int tid = threadIdx.x, lane = tid & 63, wave = __builtin_amdgcn_readfirstlane(tid >> 6);
    const int G = gridDim.x, gw = blockIdx.x * NWAVES + wave, NGW = G * NWAVES;
    unsigned char* ws = a.ws;
    float* ssq = (float*)(ws + WS_SSQ);
    bf16_t* XB = (bf16_t*)(ws + WS_XB); bf16_t* YB = (bf16_t*)(ws + WS_Y); bf16_t* RB = (bf16_t*)(ws + WS_R);
    float* out = a.out;

    { volatile LAS unsigned* MISC = (volatile LAS unsigned*)(lds + MISC_OFF); if (tid < 64) MISC[tid] = 0u; }
    __syncthreads();
    (void)xcd_barrier_post((unsigned*)ws, (volatile LAS unsigned*)(lds + MISC_OFF) + 8);
    prologue(a, lds, gw, NGW, lane, wave);
    GSYNC0();

#pragma unroll 1
    for (int ph = 0; ph < DEPTH * 8; ++ph) {
        const int l = ph >> 3, k = ph & 7;
        unsigned char* wl = ws + WS_W + (size_t)l * W_LAYER;
        if (k == 0 || k == 6) {
#ifndef NO_GU
            pg8::Gemm g{XB, (const bf16_t*)(wl + (k == 0 ? W_GU1 : W_GU2)), M, NGU, D}; pg8::StaticOrder S; S.init(M, NGU, G, (int)blockIdx.x);
            pg8::EpiGU E{RB, ssq + (size_t)(3 * l + (k == 0 ? 0 : 2)) * M * 16, FF, lds + RSC_OFF + tid * 32, -1};
            pg8::gemm_phase<pg8::EpiGU, pg8::StaticOrder, true, true>(lds, g, S, E);
#endif
        } else if (k == 1 || k == 5 || k == 7) {
#ifndef NO_RES
            const int KK = (k == 5) ? D : FF;
            pg8::Gemm g{k == 5 ? YB : RB, (const bf16_t*)(wl + (k == 1 ? W_D1 : (k == 5 ? W_OUT : W_D2))), M, D, KK}; pg8::RevOrder S; S.init(M, D, G, (int)blockIdx.x);
            pg8::EpiRes E{XB, ssq + (size_t)(3 * l + (k == 1 ? 1 : (k == 5 ? 2 : 3))) * M * 16, k == 5 ? 1.0f : 0.5f};
            pg8::gemm_phase<pg8::EpiRes, pg8::RevOrder, true, true>(lds, g, S, E);
#endif
        } else if (k == 2) {
#ifndef NO_PROJ
            pg8::Gemm g{XB, (const bf16_t*)(wl + W_IN), M, PL, D}; pg8::StaticOrder S; S.init(M, PL, G, (int)blockIdx.x);
            pg8::EpiProj E{RB, ssq + (size_t)(3 * l + 1) * M * 16, PL, lds + RSC_OFF + tid * 32, (const float*)(ws + WS_LB) + l * 512, -1};
            pg8::gemm_phase<pg8::EpiProj, pg8::StaticOrder, true, true>(lds, g, S, E);
#endif
        } else {
            MixL P{RB, YB, (bf16_t*)out  , (float*)(ws + WS_DTA), (float*)(ws + WS_EBV), a.in[7] + (size_t)l * 4 * 768, a.in[8] + (size_t)l * 768, a.in[9] + l * 8, a.in[10] + l * 8, a.in[11] + l * 8, a.in[12] + l * 512,
                   (const float*)(ws + WS_LB) + l * 512, a.in[14] + l * 64};
            if (k == 3) {
                for (int u = blockIdx.x; u < 1024; u += G) prep_ssd(P, u >> 5, u & 31);
            } else {
                if (l + 1 < DEPTH && (G <= 192 || (int)blockIdx.x >= 192)) {
                    const int cb = G > 192 ? (int)blockIdx.x - 192 : (int)blockIdx.x, cn = G > 192 ? G - 192 : G;
                    convert_layer(a, l + 1, lds, cb * NWAVES + wave, cn * NWAVES, lane, wave); __syncthreads(); }
                for (int u = blockIdx.x; u < 192; u += G) {
#ifndef NO_SSD
                    if (u < 64) ssd_unit(lds, P, u >> 1, u & 1);
#endif
#ifndef NO_HG
                    if (u >= 64) hg_unit(lds, P, u - 64);
#endif
                    __syncthreads(); }
            }
        }
        GSYNC();
    }
    { const float* fn = a.in[20]; const float* sq = ssq + (size_t)12 * M * 16;
      for (int m = gw; m < M; m += NGW) { const float rs = pg8::row_rs(sq, (unsigned)m);
          const u32x4* xr = (const u32x4*)(XB + (size_t)m * D); f32x4* orow = (f32x4*)(out + (size_t)m * D);
#pragma unroll
          for (int hlf = 0; hlf < 2; ++hlf) { const u32x4 bv = xr[64 * hlf + lane]; const f32x4 w0 = ((const f32x4*)fn)[2 * (64 * hlf + lane)], w1 = ((const f32x4*)fn)[2 * (64 * hlf + lane) + 1];
              const f32x4 b0 = {__uint_as_float(bv.x << 16), __uint_as_float(bv.x & 0xffff0000u), __uint_as_float(bv.y << 16), __uint_as_float(bv.y & 0xffff0000u)};
              const f32x4 b1 = {__uint_as_float(bv.z << 16), __uint_as_float(bv.z & 0xffff0000u), __uint_as_float(bv.w << 16), __uint_as_float(bv.w & 0xffff0000u)};
              orow[2 * (64 * hlf + lane)] = b0 * rs * w0; orow[2 * (64 * hlf + lane) + 1] = b1 * rs * w1; } } }
}

extern "C" void kernel_launch(void* const* d_in, const int* in_sizes, int n_in, void* d_out, int out_size, void* d_ws, size_t ws_size, hipStream_t stream) {
    static int grid = 0;
    if (grid == 0) {
        if (n_in != 21 || in_sizes[0] != M * D || out_size != M * D || ws_size < WS_END) { fprintf(stderr, "kernel_launch: unexpected shapes (n_in %d, in0 %d, out %d, ws %zu); nothing launched\n", n_in, n_in > 0 ? in_sizes[0] : -1, out_size, ws_size); grid = -1; return; }
        int dev = 0, cus = 0, per_cu = 0;
        if (hipGetDevice(&dev) != hipSuccess || hipDeviceGetAttribute(&cus, hipDeviceAttributeMultiprocessorCount, dev) != hipSuccess) { fprintf(stderr, "kernel_launch: device query failed\n"); grid = -1; return; }
        if (hipFuncSetAttribute((const void*)hymba_fwd, hipFuncAttributeMaxDynamicSharedMemorySize, LDS_BYTES) != hipSuccess) { fprintf(stderr, "kernel_launch: hipFuncSetAttribute failed\n"); grid = -1; return; }
        if (hipOccupancyMaxActiveBlocksPerMultiprocessor(&per_cu, (const void*)hymba_fwd, NTHR, LDS_BYTES) != hipSuccess || per_cu < 1) { fprintf(stderr, "kernel_launch: occupancy query gave %d\n", per_cu); per_cu = 1; }
        (void)hipGetLastError();
        grid = cus;
    }
    if (grid < 0) return;
    if (hipMemsetAsync(d_ws, 0, 16384, stream) != hipSuccess) { fprintf(stderr, "kernel_launch: hipMemsetAsync failed\n"); return; }
    Args a{};
    for (int i = 0; i < 21; ++i) a.in[i] = (const float*)d_in[i];
    a.out = (float*)d_out; a.ws = (unsigned char*)d_ws;
    void* args[] = {&a};
    const hipError_t e = hipLaunchCooperativeKernel((const void*)hymba_fwd, dim3(grid), dim3(NTHR), args, LDS_BYTES, stream);
    if (e != hipSuccess) fprintf(stderr, "kernel_launch: cooperative launch failed: %s (grid %d)\n", hipGetErrorString(e), grid);
}
```

```cpp
#include <hip/hip_runtime.h>
#include <hip/hip_cooperative_groups.h>
#include <cstdio>
#include <cstdint>
namespace cg = cooperative_groups;

namespace pg8 {
#define PG8_LAS __attribute__((address_space(3)))
typedef unsigned short bf16_t;
typedef short bf16x8 __attribute__((ext_vector_type(8)));
typedef float f32x4 __attribute__((ext_vector_type(4)));
typedef unsigned u32x4 __attribute__((ext_vector_type(4)));
constexpr int BM = 256, BK = 64, HALF = 128, HTB = HALF * BK * 2  , STAGE_BYTES = 8 * HTB, NXCD = 8, WGM = 8;

__host__ __device__ __forceinline__ int lds_byte(int r, int c) { const int st = (r >> 4) * 2 + (c >> 5), rr = r & 15, cc = c & 31, ob = rr * 64 + cc * 2; return st * 1024 + (ob ^ (((ob >> 9) & 1) << 5)); }
__host__ __device__ __forceinline__ void stage_rc(int b, int& R, int& C) { const int st = b / 1024, sb = b % 1024, swz = sb ^ (((sb >> 9) & 1) << 5); R = (st >> 1) * 16 + swz / 64; C = (st & 1) * 32 + (swz % 64) / 2; }
__host__ __device__ __forceinline__ int perm32(int rho) { const int n = rho >> 4, i = rho & 15; return 8 * (i >> 2) + 4 * n + (i & 3); }

struct Unit { int pm, pn; };
struct Gemm { const bf16_t* A; const bf16_t* Bt; int M, N, K; };

struct StaticOrder {
    int nM, nN, nwg, G, c;
    __host__ __device__ void init(int M, int N, int G_, int c_) { nM = M / BM; nN = N / BM; nwg = nM * nN; G = G_; c = c_; }
    __host__ __device__ bool next(int i, Unit& u) const {
        const long L = (long)i * G + c; if (L >= nwg) return false;
        int wgid = (int)L; const int xcd_ = wgid % NXCD; { const int q = nwg / NXCD, r = nwg % NXCD, xcd = wgid % NXCD, off = wgid / NXCD; wgid = (xcd < r ? xcd * (q + 1) : r * (q + 1) + (xcd - r) * q) + off; }
        const int nig = WGM * nN, gid = wgid / nig, fm = gid * WGM, gsz = (nM - fm) < WGM ? (nM - fm) : WGM;
        u.pm = fm + ((wgid % nig) % gsz); u.pn = ((wgid % nig) / gsz + (xcd_ * nN) / NXCD) % nN;
        return true;
    }
    __device__ __forceinline__ void a_ready(const Unit&) const {}
    __device__ __forceinline__ void done(const Unit&) const {}
};


typedef __bf16 bf16x2n __attribute__((ext_vector_type(2)));
typedef float f32x2n __attribute__((ext_vector_type(2)));
__device__ __forceinline__ unsigned pk2(float lo, float hi) { f32x2n v = {lo, hi}; bf16x2n b = __builtin_convertvector(v, bf16x2n); return __builtin_bit_cast(unsigned, b); }
__device__ __forceinline__ float silu_f(float x) { return x * __builtin_amdgcn_rcpf(1.0f + __expf(-x)); }

struct RevOrder : StaticOrder {
    __host__ __device__ bool next(int i, Unit& u) const { if (nwg % G != 0) return StaticOrder::next(i, u);
        const int nr = nwg / G; if (i >= nr) return false; return StaticOrder::next(nr - 1 - i, u); }
};
constexpr float RMS_EPS = 1e-6f;
__device__ __forceinline__ float row_rs(const float* ssq, unsigned row) {
    const f32x4* sp = (const f32x4*)(ssq + (size_t)row * 16); const f32x4 a = (sp[0] + sp[1]) + (sp[2] + sp[3]);
    return __builtin_amdgcn_rsqf(((a[0] + a[1]) + (a[2] + a[3])) * (1.0f / 1024.0f) + RMS_EPS);
}
#define PG8_RS8(ssq_, u_, row0_, rsv_, slot_, last_pm_) do { \
    if ((u_).pm != (last_pm_)) { _Pragma("unroll") for (int i_ = 0; i_ < 8; ++i_) (rsv_)[i_] = row_rs((ssq_), (row0_) + (i_ >> 2) * HALF + (i_ & 3) * 16); \
        *(PG8_LAS f32x4*)(slot_) = (f32x4){(rsv_)[0], (rsv_)[1], (rsv_)[2], (rsv_)[3]}; *(PG8_LAS f32x4*)((slot_) + 16) = (f32x4){(rsv_)[4], (rsv_)[5], (rsv_)[6], (rsv_)[7]}; (last_pm_) = (u_).pm; } \
    else { const f32x4 a_ = *(const PG8_LAS f32x4*)(slot_), b_ = *(const PG8_LAS f32x4*)((slot_) + 16); \
        (rsv_)[0] = a_[0]; (rsv_)[1] = a_[1]; (rsv_)[2] = a_[2]; (rsv_)[3] = a_[3]; (rsv_)[4] = b_[0]; (rsv_)[5] = b_[1]; (rsv_)[6] = b_[2]; (rsv_)[7] = b_[3]; } } while (0)
struct EpiGU {
    static constexpr bool PERM = true, AFTER_DRAIN = false;
    bf16_t* H; const float* ssq; int ldh; PG8_LAS unsigned char* slot; mutable int last_pm;
    __device__ __forceinline__ void operator()(const f32x4 (&acc)[2][2][4][2], const Unit& u, int wr, int wc, int fr, int fq) const {
        const int row0 = u.pm * BM + wr * 64 + fr, col0 = u.pn * HALF + wc * 32 + 8 * fq;
        float rsv[8]; PG8_RS8(ssq, u, row0, rsv, slot, last_pm);
#pragma unroll
        for (int ai = 0; ai < 2; ++ai)
#pragma unroll
            for (int m = 0; m < 4; ++m) { const int row = row0 + ai * HALF + m * 16; const float rs = rsv[ai * 4 + m];
                u32x4 w; unsigned wv[4];
#pragma unroll
                for (int n = 0; n < 2; ++n) { const f32x4 g = acc[ai][0][m][n] * rs, up = acc[ai][1][m][n] * rs;
                    const float h0 = silu_f(g[0]) * up[0], h1 = silu_f(g[1]) * up[1], h2 = silu_f(g[2]) * up[2], h3 = silu_f(g[3]) * up[3];
                    wv[2 * n] = pk2(h0, h1); wv[2 * n + 1] = pk2(h2, h3); }
                w.x = wv[0]; w.y = wv[1]; w.z = wv[2]; w.w = wv[3];
                *(u32x4*)(H + (size_t)row * ldh + col0) = w; }
    }
};
struct EpiRes {
    static constexpr bool PERM = true, AFTER_DRAIN = false;
    bf16_t* xb; float* ssq_out; float scale;
    __device__ __forceinline__ void operator()(const f32x4 (&acc)[2][2][4][2], const Unit& u, int wr, int wc, int fr, int fq) const {
        const unsigned row0 = u.pm * BM + wr * 64 + fr, col0 = u.pn * BM + wc * 32 + 8 * fq;
#pragma unroll
        for (int ai = 0; ai < 2; ++ai)
#pragma unroll
            for (int m = 0; m < 4; ++m) { const unsigned row = row0 + ai * HALF + m * 16; const unsigned off = row * 1024u + col0; float s = 0.f;
                const u32x4 bv0 = *(const u32x4*)(xb + off), bv1 = *(const u32x4*)(xb + off + HALF);
#pragma unroll
                for (int bj = 0; bj < 2; ++bj) { const u32x4 bv = bj ? bv1 : bv0;
                    const f32x4 b0 = {__uint_as_float(bv.x << 16), __uint_as_float(bv.x & 0xffff0000u), __uint_as_float(bv.y << 16), __uint_as_float(bv.y & 0xffff0000u)};
                    const f32x4 b1 = {__uint_as_float(bv.z << 16), __uint_as_float(bv.z & 0xffff0000u), __uint_as_float(bv.w << 16), __uint_as_float(bv.w & 0xffff0000u)};
                    const f32x4 v0 = b0 + acc[ai][bj][m][0] * scale, v1 = b1 + acc[ai][bj][m][1] * scale;
                    u32x4 w; w.x = pk2(v0[0], v0[1]); w.y = pk2(v0[2], v0[3]); w.z = pk2(v1[0], v1[1]); w.w = pk2(v1[2], v1[3]);
                    *(u32x4*)(xb + off + bj * HALF) = w;
                    s += (v0[0] * v0[0] + v0[1] * v0[1]) + (v0[2] * v0[2] + v0[3] * v0[3]) + (v1[0] * v1[0] + v1[1] * v1[1]) + (v1[2] * v1[2] + v1[3] * v1[3]); }
                s += __shfl_xor(s, 16); s += __shfl_xor(s, 32);
                if (fq == 0) ssq_out[(size_t)row * 16 + u.pn * 4 + wc] = s;
                asm volatile("" ::: "memory"); }
    }
};
struct EpiProj {
    static constexpr bool PERM = true, AFTER_DRAIN = false;
    bf16_t* P; const float* ssq; int ldp; PG8_LAS unsigned char* slot; mutable int last_pm;
    __device__ __forceinline__ void operator()(const f32x4 (&acc)[2][2][4][2], const Unit& u, int wr, int wc, int fr, int fq) const {
        const int row0 = u.pm * BM + wr * 64 + fr, col0 = u.pn * BM + wc * 32 + 8 * fq;
        float rsv[8]; PG8_RS8(ssq, u, row0, rsv, slot, last_pm);
        const bool act = (u.pn < 2) || (u.pn == 5) || (u.pn == 6) || (u.pn == 11) || (u.pn == 12);
#pragma unroll
        for (int ai = 0; ai < 2; ++ai)
#pragma unroll
            for (int m = 0; m < 4; ++m) { const int row = row0 + ai * HALF + m * 16; const float rs = rsv[ai * 4 + m];
                bf16_t* rowp = P + (size_t)row * ldp + col0;
#pragma unroll
                for (int bj = 0; bj < 2; ++bj) { f32x4 v0 = acc[ai][bj][m][0] * rs, v1 = acc[ai][bj][m][1] * rs;
                    if (act) {
#pragma unroll
                        for (int j = 0; j < 4; ++j) { v0[j] = silu_f(v0[j]); v1[j] = silu_f(v1[j]); } }
                    u32x4 w; w.x = pk2(v0[0], v0[1]); w.y = pk2(v0[2], v0[3]); w.z = pk2(v1[0], v1[1]); w.w = pk2(v1[2], v1[3]);
                    *(u32x4*)(rowp + bj * HALF) = w; } }
    }
};

template <class Epi, class Sched, bool ALIGN_EPI = false, bool SP2 = false>
__device__ __forceinline__ void gemm_phase(PG8_LAS unsigned char* lds, const Gemm g, const Sched& S, const Epi& E) {
    int tid_l = threadIdx.x; asm volatile("" : "+v"(tid_l));
    const int tid = tid_l, wid = __builtin_amdgcn_readfirstlane(tid >> 6), lane = tid & 63, wr = wid >> 2, wc = wid & 3, fr = lane & 15, fq = lane >> 4;
    const int K = g.K, nt = K / BK;
    unsigned voffA[2], voffB[2];
#pragma unroll
    for (int i = 0; i < 2; ++i) { int R, C; stage_rc(tid * 16 + i * 8192, R, C); const int Rb = Epi::PERM ? ((R & ~31) + perm32(R & 31)) : R;
        voffA[i] = (unsigned)(R * K + C) * 2u; voffB[i] = (unsigned)(Rb * K + C) * 2u; }
    const size_t kstep = (size_t)(BK * 2);
    const size_t hstep = (size_t)HALF * K * 2;
    const size_t tstep = 2 * hstep;
    const unsigned ldsw = (unsigned)wid * 1024u;
    const int aoff = lds_byte(wr * 64 + fr, fq * 8), boff = lds_byte(wc * 32 + fr, fq * 8);
#define PG8_SA(b, h) (((b) * 2 + (h)) * HTB)
#define PG8_SB(b, h) ((4 + (b) * 2 + (h)) * HTB)
#define PG8_STAGE(bufoff, gbase, voff) do { _Pragma("unroll") for (int _i = 0; _i < 2; ++_i) \
        __builtin_amdgcn_global_load_lds((const unsigned*)((const char*)(gbase) + (voff)[_i]), (PG8_LAS unsigned*)(lds + (bufoff) + ldsw + _i * 8192), 16, 0, 0); } while (0)
#define PG8_LDA(dst, b, h) do { _Pragma("unroll") for (int m = 0; m < 4; ++m) _Pragma("unroll") for (int k = 0; k < 2; ++k) dst[m][k] = *(const PG8_LAS bf16x8*)(lds + PG8_SA(b, h) + aoff + m * 2048 + k * 1024); } while (0)
#define PG8_LDB(dst, b, h) do { _Pragma("unroll") for (int n = 0; n < 2; ++n) _Pragma("unroll") for (int k = 0; k < 2; ++k) dst[n][k] = *(const PG8_LAS bf16x8*)(lds + PG8_SB(b, h) + boff + n * 2048 + k * 1024); } while (0)
#define PG8_MMA(ai, bj, At, Bt) do { __builtin_amdgcn_s_setprio(1); _Pragma("unroll") for (int m = 0; m < 4; ++m) _Pragma("unroll") for (int n = 0; n < 2; ++n) _Pragma("unroll") for (int k = 0; k < 2; ++k) \
        acc[ai][bj][m][n] = __builtin_amdgcn_mfma_f32_16x16x32_bf16(Bt[n][k], At[m][k], acc[ai][bj][m][n], 0, 0, 0); __builtin_amdgcn_s_setprio(0); } while (0)
#define PG8_WAIT_V(n) asm volatile("s_waitcnt vmcnt(" #n ")" ::: "memory")
#define PG8_WAIT_L(n) asm volatile("s_waitcnt lgkmcnt(" #n ")" ::: "memory")
#define PG8_BAR __builtin_amdgcn_s_barrier()
#define PG8_SCHED __builtin_amdgcn_sched_barrier(0)
    Unit cur, nxt; int ui = 0;
    if (!S.next(0, cur)) return;
    f32x4 acc[2][2][4][2];
#pragma unroll
    for (int a = 0; a < 2; ++a)
#pragma unroll
        for (int b = 0; b < 2; ++b)
#pragma unroll
            for (int m = 0; m < 4; ++m)
#pragma unroll
                for (int n = 0; n < 2; ++n) acc[a][b][m][n] = (f32x4){0.f, 0.f, 0.f, 0.f};
    bf16x8 At[4][2], B0[2][2], B1[2][2];
    const char* cA = (const char*)g.A + (size_t)cur.pm * tstep; const char* cB = (const char*)g.Bt + (size_t)cur.pn * tstep;
    S.a_ready(cur);
    if constexpr (SP2) {
        PG8_STAGE(PG8_SB(0, 0), cB, voffB); PG8_STAGE(PG8_SB(0, 1), cB + hstep, voffB); PG8_STAGE(PG8_SA(0, 0), cA, voffA); PG8_STAGE(PG8_SA(0, 1), cA + hstep, voffA);
        if (wr == 1) PG8_BAR;
        PG8_WAIT_V(2); PG8_BAR;
        PG8_STAGE(PG8_SB(1, 0), cB + kstep, voffB); PG8_STAGE(PG8_SA(1, 0), cA + kstep, voffA); PG8_STAGE(PG8_SB(1, 1), cB + hstep + kstep, voffB);
        PG8_WAIT_V(6); PG8_BAR;
    } else {
        PG8_STAGE(PG8_SB(0, 0), cB, voffB); PG8_STAGE(PG8_SA(0, 0), cA, voffA); PG8_STAGE(PG8_SB(0, 1), cB + hstep, voffB); PG8_STAGE(PG8_SA(0, 1), cA + hstep, voffA);
        if (wr == 1) PG8_BAR;
        PG8_WAIT_V(4); PG8_BAR;
        PG8_STAGE(PG8_SB(1, 0), cB + kstep, voffB); PG8_STAGE(PG8_SA(1, 0), cA + kstep, voffA); PG8_STAGE(PG8_SB(1, 1), cB + hstep + kstep, voffB);
        PG8_WAIT_V(6); PG8_BAR;
    }
    for (;;) {
        const bool has_next = S.next(ui + 1, nxt);
        const char* nA = has_next ? (const char*)g.A + (size_t)nxt.pm * tstep : cA; const char* nB = has_next ? (const char*)g.Bt + (size_t)nxt.pn * tstep : cB;
        for (int t = 0; t < nt; t += 2) {
            const bool last = (t == nt - 2);
            const char* a1 = cA + (size_t)(t + 1) * kstep;
            const char* a2 = last ? nA : cA + (size_t)(t + 2) * kstep; const char* b2 = last ? nB : cB + (size_t)(t + 2) * kstep;
            const char* a3 = a2 + kstep; const char* b3 = b2 + kstep;
            if (last && has_next) S.a_ready(nxt);
            if constexpr (SP2) {
            PG8_LDB(B0, 0, 0); PG8_LDB(B1, 0, 1); PG8_SCHED; PG8_LDA(At, 0, 0); PG8_STAGE(PG8_SA(1, 1), a1 + hstep, voffA);
            PG8_WAIT_V(8); PG8_WAIT_L(0); PG8_BAR; PG8_MMA(0, 0, At, B0); PG8_MMA(0, 1, At, B1); PG8_BAR; PG8_SCHED;
            PG8_LDA(At, 0, 1); PG8_STAGE(PG8_SB(0, 0), b2, voffB); PG8_STAGE(PG8_SB(0, 1), b2 + hstep, voffB); PG8_STAGE(PG8_SA(0, 0), a2, voffA);
            PG8_WAIT_V(8); PG8_WAIT_L(0); PG8_BAR; PG8_MMA(1, 0, At, B0); PG8_MMA(1, 1, At, B1); PG8_BAR; PG8_SCHED;
            PG8_LDB(B0, 1, 0); PG8_LDB(B1, 1, 1); PG8_SCHED; PG8_LDA(At, 1, 0); PG8_STAGE(PG8_SA(0, 1), a2 + hstep, voffA);
            PG8_WAIT_V(8); PG8_WAIT_L(0); PG8_BAR; PG8_MMA(0, 0, At, B0); PG8_MMA(0, 1, At, B1); PG8_BAR; PG8_SCHED;
            PG8_LDA(At, 1, 1); PG8_STAGE(PG8_SB(1, 0), b3, voffB); PG8_STAGE(PG8_SB(1, 1), b3 + hstep, voffB); PG8_STAGE(PG8_SA(1, 0), a3, voffA);
            PG8_WAIT_V(8); PG8_WAIT_L(0); PG8_BAR; PG8_MMA(1, 0, At, B0); PG8_MMA(1, 1, At, B1); PG8_BAR; PG8_SCHED;
            } else {
            PG8_LDB(B0, 0, 0); PG8_SCHED; PG8_LDA(At, 0, 0); PG8_STAGE(PG8_SA(1, 1), a1 + hstep, voffA);
            PG8_WAIT_L(8); PG8_BAR; PG8_WAIT_L(0); PG8_MMA(0, 0, At, B0); PG8_BAR; PG8_SCHED;
            PG8_LDB(B1, 0, 1); PG8_STAGE(PG8_SB(0, 0), b2, voffB);
            PG8_BAR; PG8_WAIT_L(0); PG8_MMA(0, 1, At, B1); PG8_BAR;
            PG8_LDA(At, 0, 1); PG8_STAGE(PG8_SA(0, 0), a2, voffA);
            PG8_BAR; PG8_WAIT_L(0); PG8_MMA(1, 0, At, B0); PG8_BAR; PG8_SCHED;
            PG8_STAGE(PG8_SB(0, 1), b2 + hstep, voffB);
            PG8_WAIT_V(6); PG8_BAR; PG8_MMA(1, 1, At, B1); PG8_BAR;
            PG8_LDB(B0, 1, 0); PG8_SCHED; PG8_LDA(At, 1, 0); PG8_STAGE(PG8_SA(0, 1), a2 + hstep, voffA);
            PG8_WAIT_L(8); PG8_BAR; PG8_WAIT_L(0); PG8_MMA(0, 0, At, B0); PG8_BAR; PG8_SCHED;
            PG8_LDB(B1, 1, 1); PG8_STAGE(PG8_SB(1, 0), b3, voffB);
            PG8_BAR; PG8_WAIT_L(0); PG8_MMA(0, 1, At, B1); PG8_BAR;
            PG8_LDA(At, 1, 1); PG8_STAGE(PG8_SA(1, 0), a3, voffA);
            PG8_BAR; PG8_WAIT_L(0); PG8_MMA(1, 0, At, B0); PG8_BAR; PG8_SCHED;
            PG8_STAGE(PG8_SB(1, 1), b3 + hstep, voffB);
            PG8_WAIT_V(6); PG8_BAR; PG8_MMA(1, 1, At, B1); PG8_BAR;
            }
        }
        if constexpr (ALIGN_EPI) { if (wr == 0) PG8_BAR; }
        if constexpr (!Epi::AFTER_DRAIN) { E(acc, cur, wr, wc, fr, fq); S.done(cur); }
        if (!has_next) break;
#pragma unroll
        for (int a = 0; a < 2; ++a)
#pragma unroll
            for (int b = 0; b < 2; ++b)
#pragma unroll
                for (int m = 0; m < 4; ++m)
#pragma unroll
                    for (int n = 0; n < 2; ++n) acc[a][b][m][n] = (f32x4){0.f, 0.f, 0.f, 0.f};
        cur = nxt; cA = nA; cB = nB; ++ui;
        if constexpr (ALIGN_EPI) { if (wr == 1) PG8_BAR; }
    }
    PG8_WAIT_V(0);
    if constexpr (!ALIGN_EPI) { if (wr == 0) PG8_BAR; }
    PG8_BAR;
    if constexpr (Epi::AFTER_DRAIN) { E.fused(acc, cur, wr, wc, fr, fq, lds, wid, lane); S.done(cur); }
#undef PG8_SA
#undef PG8_SB
#undef PG8_STAGE
#undef PG8_LDA
#undef PG8_LDB
#undef PG8_MMA
#undef PG8_WAIT_V
#undef PG8_WAIT_L
#undef PG8_BAR
#undef PG8_SCHED
}
}

#define DI __device__ __forceinline__
#define LAS __attribute__((address_space(3)))
typedef unsigned short bf16_t;
typedef short bf16x8 __attribute__((ext_vector_type(8)));
typedef short s16x4 __attribute__((ext_vector_type(4)));
typedef float f32x4 __attribute__((ext_vector_type(4)));
typedef unsigned u32x4 __attribute__((ext_vector_type(4)));
typedef unsigned u32x2 __attribute__((ext_vector_type(2)));
using pg8::pk2; using pg8::silu_f;

constexpr int NWAVES = 8, NTHR = 512;
constexpr int M = 65536, D = 1024, FF = 2816, NGU = 2 * FF, PL = 3584, SEQ = 2048, DEPTH = 4, DPROJ = 3336;
constexpr int LDS_BYTES = 131072 + 256 + 16384, MISC_OFF = 131072, RSC_OFF = 131072 + 256;
constexpr size_t MiB = 1u << 20;
constexpr size_t WS_SSQ = 880 * MiB;
constexpr size_t WS_LB = 5 * MiB;
constexpr size_t WS_W = 8 * MiB;
constexpr size_t W_GU1 = 0, W_D1 = 11 * MiB, W_IN = W_D1 + 11 * MiB / 2, W_OUT = W_IN + 7 * MiB, W_GU2 = W_OUT + 2 * MiB, W_D2 = W_GU2 + 11 * MiB, W_LAYER = 42 * MiB;
static_assert(W_D2 + 11 * MiB / 2 == W_LAYER, "weight map");
constexpr size_t WS_XB = 176 * MiB;
constexpr size_t WS_Y = 304 * MiB;
constexpr size_t WS_R = 432 * MiB;
constexpr size_t WS_DTA = 932 * MiB;
constexpr size_t WS_EBV = 948 * MiB;
constexpr size_t WS_END = 956 * MiB;
static_assert(WS_W + 4 * W_LAYER == WS_XB && WS_R + (size_t)M * PL * 2 == WS_SSQ && WS_SSQ + 13 * 4 * MiB == WS_DTA, "ws map");

DI float bf2f(unsigned short h) { return __uint_as_float((unsigned)h << 16); }
DI float wave_sum(float v) {
#pragma unroll
    for (int o = 1; o < 64; o <<= 1) v += __shfl_xor(v, o);
    return v;
}
#define LDS_WAIT() asm volatile("s_waitcnt lgkmcnt(0)" ::: "memory")
DI f32x4 mma(bf16x8 a, bf16x8 b, f32x4 c) { return __builtin_amdgcn_mfma_f32_16x16x32_bf16(a, b, c, 0, 0, 0); }
DI bf16x8 pack8(f32x4 a, f32x4 b) { u32x4 w; w.x = pk2(a[0], a[1]); w.y = pk2(a[2], a[3]); w.z = pk2(b[0], b[1]); w.w = pk2(b[2], b[3]); return __builtin_bit_cast(bf16x8, w); }
constexpr int LS = 144;
DI bf16x8 ld_perm(const LAS unsigned char* base, int row, int kk, int q) {
    const LAS unsigned char* p = base + row * LS + kk * 64 + q * 8;
    const s16x4 lo = *(const LAS s16x4*)p, hi = *(const LAS s16x4*)(p + 32);
    return __builtin_shufflevector(lo, hi, 0, 1, 2, 3, 4, 5, 6, 7);
}
DI bf16x8 scale8(bf16x8 x, f32x4 wlo, f32x4 whi) {
    const u32x4 u = __builtin_bit_cast(u32x4, x);
    f32x4 a, b;
    a[0] = __uint_as_float(u.x << 16) * wlo[0]; a[1] = __uint_as_float(u.x & 0xffff0000u) * wlo[1];
    a[2] = __uint_as_float(u.y << 16) * wlo[2]; a[3] = __uint_as_float(u.y & 0xffff0000u) * wlo[3];
    b[0] = __uint_as_float(u.z << 16) * whi[0]; b[1] = __uint_as_float(u.z & 0xffff0000u) * whi[1];
    b[2] = __uint_as_float(u.w << 16) * whi[2]; b[3] = __uint_as_float(u.w & 0xffff0000u) * whi[3];
    return pack8(a, b);
}

#define XB_TMO      128
#define XB_XCNT(j)  (256  + 64 * (j))
#define XB_XSUB(j)  (1280 + 64 * (j))
#define XB_XGEN(j)  (2304 + 64 * (j))
#define XB_TOP      3328
#define XB_TOPGEN   3392
#define XCD_BAR_WORDS 3456
#define XB_SPIN_CAP (1u << 18)

__device__ __forceinline__ unsigned xb_ld(unsigned* p)              { return __hip_atomic_load(p, __ATOMIC_RELAXED, __HIP_MEMORY_SCOPE_AGENT); }
__device__ __forceinline__ unsigned xb_add(unsigned* p, unsigned v) { return __hip_atomic_fetch_add(p, v, __ATOMIC_RELAXED, __HIP_MEMORY_SCOPE_AGENT); }
__device__ __forceinline__ unsigned xb_xcc_id() { return (unsigned)__builtin_amdgcn_s_getreg((3 << 11) | 20) & 0xFu; }
#define XB_SPIN(cond, bar) do { unsigned _sp = 0; while (cond) { __builtin_amdgcn_s_sleep(1); \
    if ((++_sp & 255u) == 0u) { if (xb_ld(&(bar)[XB_TMO])) break; if (_sp > XB_SPIN_CAP) { atomicAdd(&(bar)[XB_TMO], 1u); break; } } } } while (0)

struct XcdBarrier {
    unsigned* bar; unsigned x;
    volatile LAS unsigned* st;
};

__device__ __forceinline__ XcdBarrier xcd_barrier_post(unsigned* bar, volatile LAS unsigned* st) {
    XcdBarrier b; b.bar = bar; b.x = xb_xcc_id(); b.st = st;
    if (threadIdx.x == 0) (void)xb_add(&bar[XB_XCNT(b.x)], 1u);
    return b;
}
__device__ __forceinline__ void xcd_barrier_complete(unsigned* bar, unsigned x, unsigned& nloc, unsigned& nx) {
    const unsigned G = gridDim.x * gridDim.y * gridDim.z;
    unsigned sum, cnt, mine, sp = 0u;
    for (;;) {
        sum = 0u; cnt = 0u; mine = 0u;
#pragma unroll
        for (unsigned j = 0; j < 16; ++j) { const unsigned c = xb_ld(&bar[XB_XCNT(j)]); sum += c; cnt += (c > 0u) ? 1u : 0u; mine = (j == x) ? c : mine; }
        if (sum == G) break;
        __builtin_amdgcn_s_sleep(1);
        if ((++sp & 255u) == 0u) { if (xb_ld(&bar[XB_TMO])) break; if (sp > XB_SPIN_CAP) { atomicAdd(&bar[XB_TMO], 1u); break; } }
    }
    nloc = mine > 0u ? mine : 1u; nx = cnt > 0u ? cnt : 1u;
}

__device__ __forceinline__ void xcd_barrier(const XcdBarrier& b) {
    asm volatile("s_waitcnt vmcnt(0)" ::: "memory");
    __syncthreads();
    if (threadIdx.x == 0) {
        unsigned* bar = b.bar;
        __builtin_amdgcn_s_waitcnt(0);
        unsigned nloc = b.st[0], nx = b.st[1];
        if (nloc == 0u) { xcd_barrier_complete(bar, b.x, nloc, nx); b.st[0] = nloc; b.st[1] = nx; }
        const unsigned old = xb_add(&bar[XB_XSUB(b.x)], 1u);
        const unsigned gen = old / nloc;
        if (old + 1u == (gen + 1u) * nloc) {
            __builtin_amdgcn_fence(__ATOMIC_RELEASE, "agent");
            asm volatile("s_waitcnt vmcnt(0)" ::: "memory");
            const unsigned og = xb_add(&bar[XB_TOP], 1u);
            const unsigned tg = og / nx;
            if (og + 1u == (tg + 1u) * nx) xb_add(&bar[XB_TOPGEN], 1u);
            else XB_SPIN(xb_ld(&bar[XB_TOPGEN]) == tg, bar);
            __builtin_amdgcn_fence(__ATOMIC_ACQUIRE, "agent");
            xb_add(&bar[XB_XGEN(b.x)], 1u);
            asm volatile("s_waitcnt vmcnt(0)" ::: "memory");
        } else {
            XB_SPIN(xb_ld(&bar[XB_XGEN(b.x)]) == gen, bar);
            __builtin_amdgcn_fence(__ATOMIC_ACQUIRE, "agent");
            asm volatile("s_waitcnt vmcnt(0)" ::: "memory");
        }
    }
    __syncthreads();
}

DI void p0_item(const float* W, int ldsrc, int k0, int src_col0, int nvalid, const float* normw, bf16_t* WT, int ldk, int dst_row0, LAS float* scr, int lane) {
    const int c = lane & 31;
#pragma unroll
    for (int i = 0; i < 32; ++i) { const int kk = 2 * i + (lane >> 5);
        float v = (c < nvalid) ? W[(size_t)(k0 + kk) * ldsrc + src_col0 + c] : 0.f;
        if (normw) v *= normw[k0 + kk];
        scr[kk * 33 + c] = v; }
    LDS_WAIT(); asm volatile("" ::: "memory");
    const int c8 = lane & 7;
#pragma unroll
    for (int j = 0; j < 4; ++j) { const int n = (lane >> 3) + 8 * j; const LAS float* s = scr + (8 * c8) * 33 + n;
        u32x4 o; o.x = pk2(s[0 * 33], s[1 * 33]); o.y = pk2(s[2 * 33], s[3 * 33]); o.z = pk2(s[4 * 33], s[5 * 33]); o.w = pk2(s[6 * 33], s[7 * 33]);
        *(u32x4*)(WT + (size_t)(dst_row0 + n) * ldk + k0 + 8 * c8) = o; }
    LDS_WAIT(); asm volatile("" ::: "memory");
}

struct Args { const float* in[21]; float* out; unsigned char* ws; };

DI void convert_layer(const Args& a, int l, LAS unsigned char* lds, int gw, int NGW, int lane_in, int wave) {
    int lane = lane_in; asm volatile("" : "+v"(lane));
    unsigned char* ws = a.ws;
    LAS float* scr = (LAS float*)(lds + wave * 16384);
    constexpr int I_GU = (NGU / 32) * (D / 64), I_D = (D / 32) * (FF / 64), I_IN = (PL / 32) * (D / 64), I_OUT = (D / 32) * (D / 64);
    constexpr int I_LAYER = 2 * I_GU + 2 * I_D + I_IN + I_OUT;
    unsigned char* wl = ws + WS_W + (size_t)l * W_LAYER;
    for (int it = gw; it < I_LAYER; it += NGW) {
        int r = it;
        int which = 0;
        if (r >= I_GU) { r -= I_GU; which = 1; if (r >= I_D) { r -= I_D; which = 2; if (r >= I_IN) { r -= I_IN; which = 3; if (r >= I_OUT) { r -= I_OUT; which = 4; if (r >= I_GU) { r -= I_GU; which = 5; } } } } }
        if (which == 0 || which == 4) {
            const int nblk = NGU / 32, kb = r / nblk, nb = r % nblk, pn = nb >> 3, j = nb & 7;
            const float* src = (j < 4) ? a.in[which == 0 ? 2 : 17] : a.in[which == 0 ? 3 : 18];
            const float* nw = a.in[which == 0 ? 1 : 16] + (size_t)l * D;
            p0_item(src + (size_t)l * D * FF, FF, 64 * kb, 128 * pn + 32 * (j & 3), 32, nw, (bf16_t*)(wl + (which == 0 ? W_GU1 : W_GU2)), D, 32 * nb, scr, lane);
        } else if (which == 1 || which == 5) {
            const int nblk = D / 32, kb = r / nblk, nb = r % nblk;
            p0_item(a.in[which == 1 ? 4 : 19] + (size_t)l * FF * D, D, 64 * kb, 32 * nb, 32, nullptr, (bf16_t*)(wl + (which == 1 ? W_D1 : W_D2)), FF, 32 * nb, scr, lane);
        } else if (which == 2) {
            const int nblk = PL / 32, kb = r / nblk, nb = r % nblk;
            int sc, nv;
            if (nb < 40) { sc = 32 * nb; nv = 32; } else if (nb < 104) { sc = 32 * nb + 8; nv = 32; } else if (nb == 104) { sc = 1280; nv = 8; } else { sc = 0; nv = 0; }
            p0_item(a.in[6] + (size_t)l * D * DPROJ, DPROJ, 64 * kb, sc, nv, a.in[5] + (size_t)l * D, (bf16_t*)(wl + W_IN), D, 32 * nb, scr, lane);
        } else {
            const int nblk = D / 32, kb = r / nblk, nb = r % nblk;
            p0_item(a.in[15] + (size_t)l * D * D, D, 64 * kb, 32 * nb, 32, nullptr, (bf16_t*)(wl + W_OUT), D, 32 * nb, scr, lane);
        }
    }
}

DI void prologue(const Args& a, LAS unsigned char* lds, int gw, int NGW, int lane, int wave) {
    unsigned char* ws = a.ws;
    if (blockIdx.x == 0) { const int c = threadIdx.x; const float* lg = a.in[13];
        const float x0 = lg[c], x1 = lg[512 + c], x2 = lg[1024 + c], x3 = lg[1536 + c]; const float mx = fmaxf(fmaxf(x0, x1), fmaxf(x2, x3));
        const float e0 = __expf(x0 - mx), e1 = __expf(x1 - mx), e2 = __expf(x2 - mx), e3 = __expf(x3 - mx); const float inv = 1.0f / (e0 + e1 + e2 + e3);
        float* LB = (float*)(ws + WS_LB); LB[c] = 0.f; LB[512 + c] = e1 * inv; LB[1024 + c] = (e1 + e2) * inv; LB[1536 + c] = (e1 + e2 + e3) * inv; }
    { const float* x = a.in[0]; bf16_t* XB = (bf16_t*)(ws + WS_XB); float* ssq0 = (float*)(ws + WS_SSQ);
      for (int m0 = gw; m0 < M; m0 += 2 * NGW) { f32x4 v[2][4];
#pragma unroll
          for (int h = 0; h < 2; ++h) { const int m = m0 + h * NGW; const f32x4* xr = (const f32x4*)(x + (size_t)m * D) + lane;
#pragma unroll
              for (int j = 0; j < 4; ++j) v[h][j] = xr[64 * j]; }
#pragma unroll
          for (int h = 0; h < 2; ++h) { const int m = m0 + h * NGW; float s = 0.f;
#pragma unroll
              for (int j = 0; j < 4; ++j) s += (v[h][j].x * v[h][j].x + v[h][j].y * v[h][j].y) + (v[h][j].z * v[h][j].z + v[h][j].w * v[h][j].w);
              s = wave_sum(s);
              u32x2* o8 = (u32x2*)(XB + (size_t)m * D) + lane;
#pragma unroll
              for (int j = 0; j < 4; ++j) { u32x2 w; w.x = pk2(v[h][j].x, v[h][j].y); w.y = pk2(v[h][j].z, v[h][j].w); o8[64 * j] = w; }
              if (lane < 16) ssq0[(size_t)m * 16 + lane] = (lane == 0) ? s : 0.f; } } }
    convert_layer(a, 0, lds, gw, NGW, lane, wave);
}

struct MixL { bf16_t* proj; bf16_t* Y; bf16_t* XA; float* DTA; float* EBV; const float *conv_w, *conv_b, *dt_bias, *a_log, *dskip, *ssd_nw, *lb, *hg_nw; };


constexpr int SSD_STG = 73728, SSD_DT2 = 122880;
DI void ssd_dma(LAS unsigned char* lds, const MixL& P, size_t rowbase, int b, int g, int c, int tid, int wave) {
    const int t0 = c * 64;
    { const int cgi = tid & 31, run = tid >> 5;
      const int c0 = 256 * g + 8 * cgi;
#pragma unroll
      for (int j = 0; j < 4; ++j) __builtin_amdgcn_global_load_lds((const unsigned*)(P.XA + (rowbase + t0 + 4 * run + j) * 768 + c0), (LAS unsigned*)(lds + SSD_STG + j * 8192 + wave * 1024), 16, 0, 0); }
    if (wave < 4) { const int run = (tid & 127) >> 3;
      const int c0 = (wave < 2 ? 512 : 640) + 64 * g + 8 * (tid & 7);
#pragma unroll
      for (int j = 0; j < 4; ++j) __builtin_amdgcn_global_load_lds((const unsigned*)(P.XA + (rowbase + t0 + 4 * run + j) * 768 + c0), (LAS unsigned*)(lds + SSD_STG + 32768 + j * 4096 + wave * 1024), 16, 0, 0);
      __builtin_amdgcn_global_load_lds((const unsigned*)(P.DTA + (size_t)(b * 32 + c) * 2048 + wave * 512 + (4 * g + ((tid & 63) >> 4)) * 64 + 4 * (tid & 15)), (LAS unsigned*)(lds + SSD_DT2 + wave * 1024), 16, 0, 0); }
}
DI void ssd_unit(LAS unsigned char* lds, const MixL& P, int b, int g) {
    int tid_l = threadIdx.x; asm volatile("" : "+v"(tid_l));
    const int tid = tid_l, lane = tid & 63, wave = __builtin_amdgcn_readfirstlane(tid >> 6), l15 = lane & 15, q = lane >> 4;
    const int r = wave >> 1, hh = wave & 1;
    LAS unsigned char* XT = lds; LAS unsigned char* BMp = lds + 36864; LAS unsigned char* BTp = lds + 46080; LAS unsigned char* CMp = lds + 55296;
    LAS float* ACUM = (LAS float*)(lds + 64512); LAS float* DTV = ACUM + 256; LAS float* EA = ACUM + 512; LAS float* WV = ACUM + 768; LAS float* SSQP = ACUM + 1024;
    const float Dr = P.dskip[4 * g + r];
    const size_t rowbase = (size_t)b * SEQ;
    const int ycol = 256 * g + 64 * r + 32 * hh + 4 * q;
    const LAS unsigned char* XTr = XT + r * 64 * LS;
    const LAS float* ac = ACUM + r * 64; const LAS float* dtv = DTV + r * 64; const LAS float* ea = EA + r * 64; const LAS float* wv = WV + r * 64;
    f32x4 ST[4][2];
#pragma unroll
    for (int i = 0; i < 4; ++i)
#pragma unroll
        for (int j = 0; j < 2; ++j) ST[i][j] = (f32x4){0.f, 0.f, 0.f, 0.f};
    f32x4 nwv[2];
#pragma unroll
    for (int pt = 0; pt < 2; ++pt) nwv[pt] = *(const f32x4*)(P.ssd_nw + ycol + 16 * pt);
    ssd_dma(lds, P, rowbase, b, g, 0, tid, wave);
#pragma unroll 1
    for (int c = 0; c < SEQ / 64; ++c) {
        const int t0 = c * 64;
        asm volatile("s_waitcnt vmcnt(0)" ::: "memory");
#pragma unroll
        for (int pass = 0; pass < 2; ++pass) {
            if (pass == 0 || wave < 4) {
            const int cgi = pass ? (wave < 2 ? 32 : 40) + (tid & 7) : (tid & 31), run = pass ? ((tid & 127) >> 3) : (tid >> 5);
            u32x4 rv[4];
#pragma unroll
            for (int j = 0; j < 4; ++j) rv[j] = *(const LAS u32x4*)(lds + SSD_STG + (pass ? 32768 + j * 4096 : j * 8192) + tid * 16);
            u32x2 tv[8];
#pragma unroll
            for (int e = 0; e < 8; ++e) { const unsigned a0 = rv[0][e >> 1], a1 = rv[1][e >> 1], a2 = rv[2][e >> 1], a3 = rv[3][e >> 1];
                if (e & 1) { tv[e].x = (a0 >> 16) | (a1 & 0xffff0000u); tv[e].y = (a2 >> 16) | (a3 & 0xffff0000u); }
                else { tv[e].x = (a0 & 0xffffu) | (a1 << 16); tv[e].y = (a2 & 0xffffu) | (a3 << 16); } }
            if (cgi < 32) { const int rr = cgi >> 3, p0 = 8 * (cgi & 7);
#pragma unroll
                for (int e = 0; e < 8; ++e) *(LAS u32x2*)(XT + (rr * 64 + p0 + e) * LS + ((run ^ ((cgi & 1) | (((cgi >> 2) & 7) << 1))) << 3)) = tv[e];
            } else if (cgi < 40) { const int n0 = 8 * (cgi - 32);
#pragma unroll
                for (int j = 0; j < 4; ++j) *(LAS u32x4*)(BMp + (4 * run + j) * LS + n0 * 2) = rv[j];
#pragma unroll
                for (int e = 0; e < 8; ++e) *(LAS u32x2*)(BTp + (n0 + e) * LS + run * 8) = tv[e];
            } else { const int n0 = 8 * (cgi - 40);
#pragma unroll
                for (int j = 0; j < 4; ++j) *(LAS u32x4*)(CMp + (4 * run + j) * LS + n0 * 2) = rv[j];
            }
            }
        }
        if (wave < 4) *(LAS u32x4*)(ACUM + 4 * tid) = *(const LAS u32x4*)(lds + SSD_DT2 + tid * 16);
        __syncthreads();
        u32x2 zr[2][4];
#pragma unroll
        for (int pt = 0; pt < 2; ++pt)
#pragma unroll
            for (int ti = 0; ti < 4; ++ti) zr[pt][ti] = *(const u32x2*)(P.proj + (rowbase + t0 + 16 * ti + l15) * PL + ycol + 16 * pt);
        if (c + 1 < SEQ / 64) ssd_dma(lds, P, rowbase, b, g, c + 1, tid, wave);
        bf16x8 bmp[4][2], cmp[4][2], xtp[2][2];
#pragma unroll
        for (int i = 0; i < 4; ++i)
#pragma unroll
            for (int kk = 0; kk < 2; ++kk) { bmp[i][kk] = ld_perm(BMp, 16 * i + l15, kk, q); cmp[i][kk] = ld_perm(CMp, 16 * i + l15, kk, q); }
#pragma unroll
        for (int pt = 0; pt < 2; ++pt)
#pragma unroll
            for (int kk = 0; kk < 2; ++kk) { const int gsw = (l15 >> 3) | (hh << 1) | (r << 2);
                const LAS unsigned char* pr_ = XTr + (32 * hh + 16 * pt + l15) * LS;
                const s16x4 lo_ = *(const LAS s16x4*)(pr_ + (((kk * 8 + q) ^ gsw) << 3)), hi_ = *(const LAS s16x4*)(pr_ + (((kk * 8 + q + 4) ^ gsw) << 3));
                xtp[pt][kk] = __builtin_shufflevector(lo_, hi_, 0, 1, 2, 3, 4, 5, 6, 7); }
        float at[4], eat[4]; f32x4 as4[4], ds4[4];
#pragma unroll
        for (int i = 0; i < 4; ++i) { at[i] = ac[16 * i + l15]; eat[i] = ea[16 * i + l15]; as4[i] = *(const LAS f32x4*)(ac + 16 * i + 4 * q); ds4[i] = *(const LAS f32x4*)(dtv + 16 * i + 4 * q); }
        const float eaend = ea[63];
        f32x4 y[2][4];
#pragma unroll
        for (int ti = 0; ti < 4; ++ti) {
            f32x4 lt[4];
#pragma unroll
            for (int sj = 0; sj < 4; ++sj) {
                if (sj <= ti) {
                    f32x4 ga = (f32x4){0.f, 0.f, 0.f, 0.f};
                    ga = mma(bmp[sj][0], cmp[ti][0], ga); ga = mma(bmp[sj][1], cmp[ti][1], ga);
#pragma unroll
                    for (int rr = 0; rr < 4; ++rr) { float v = ga[rr] * __expf(at[ti] - as4[sj][rr]) * ds4[sj][rr];
                        if (sj == ti) { const int sl = 4 * q + rr; v = (sl <= l15) ? v : 0.f; v = (sl == l15) ? v + Dr : v; }
                        lt[sj][rr] = v; }
                } else lt[sj] = (f32x4){0.f, 0.f, 0.f, 0.f};
            }
            const bf16x8 lf0 = pack8(lt[0], lt[1]), lf1 = pack8(lt[2], lt[3]);
#pragma unroll
            for (int pt = 0; pt < 2; ++pt) { f32x4 a = (f32x4){0.f, 0.f, 0.f, 0.f}; a = mma(xtp[pt][0], lf0, a); if (ti >= 2) a = mma(xtp[pt][1], lf1, a); y[pt][ti] = a; }
        }
#pragma unroll
        for (int pt = 0; pt < 2; ++pt) { const bf16x8 sf0 = pack8(ST[0][pt], ST[1][pt]), sf1 = pack8(ST[2][pt], ST[3][pt]);
#pragma unroll
            for (int ti = 0; ti < 4; ++ti) { f32x4 a = (f32x4){0.f, 0.f, 0.f, 0.f}; a = mma(sf0, cmp[ti][0], a); a = mma(sf1, cmp[ti][1], a); y[pt][ti] += a * eat[ti]; } }
        { bf16x8 xw[2][2];
#pragma unroll
          for (int kk = 0; kk < 2; ++kk) { const f32x4 wlo = *(const LAS f32x4*)(wv + 32 * kk + 4 * q), whi = *(const LAS f32x4*)(wv + 32 * kk + 16 + 4 * q);
#pragma unroll
              for (int pt = 0; pt < 2; ++pt) xw[pt][kk] = scale8(xtp[pt][kk], wlo, whi); }
#pragma unroll
          for (int nj = 0; nj < 4; ++nj) { const bf16x8 b0 = ld_perm(BTp, 16 * nj + l15, 0, q), b1 = ld_perm(BTp, 16 * nj + l15, 1, q);
#pragma unroll
              for (int pt = 0; pt < 2; ++pt) { f32x4 a = ST[nj][pt] * eaend; a = mma(b0, xw[pt][0], a); a = mma(b1, xw[pt][1], a); ST[nj][pt] = a; } } }
        float sq[4] = {0.f, 0.f, 0.f, 0.f};
#pragma unroll
        for (int pt = 0; pt < 2; ++pt)
#pragma unroll
            for (int ti = 0; ti < 4; ++ti) { const u32x2 zz = zr[pt][ti];
                const float z0 = __uint_as_float(zz.x << 16), z1 = __uint_as_float(zz.x & 0xffff0000u), z2 = __uint_as_float(zz.y << 16), z3 = __uint_as_float(zz.y & 0xffff0000u);
                f32x4 v = y[pt][ti]; v[0] *= z0; v[1] *= z1; v[2] *= z2; v[3] *= z3; y[pt][ti] = v;
                sq[ti] += (v[0] * v[0] + v[1] * v[1]) + (v[2] * v[2] + v[3] * v[3]); }
#pragma unroll
        for (int ti = 0; ti < 4; ++ti) { float s = sq[ti]; s += __shfl_xor(s, 16); s += __shfl_xor(s, 32); if (q == 0) SSQP[wave * 64 + 16 * ti + l15] = s; }
        asm volatile("s_waitcnt lgkmcnt(0)" ::: "memory"); __builtin_amdgcn_s_barrier(); asm volatile("" ::: "memory");
#pragma unroll
        for (int ti = 0; ti < 4; ++ti) { float tot = 0.f;
#pragma unroll
            for (int w8 = 0; w8 < 8; ++w8) tot += SSQP[w8 * 64 + 16 * ti + l15];
            const float rs = __builtin_amdgcn_rsqf(tot * (1.0f / 256.0f) + pg8::RMS_EPS);
#pragma unroll
            for (int pt = 0; pt < 2; ++pt) { const f32x4 o = y[pt][ti] * rs * nwv[pt];
                u32x2 w2; w2.x = pk2(o[0], o[1]); w2.y = pk2(o[2], o[3]);
                *(u32x2*)(P.Y + (rowbase + t0 + 16 * ti + l15) * D + ycol + 16 * pt) = w2; } }
    }
}


constexpr int HG_STG = 81920;
DI void hg_dma(LAS unsigned char* lds, const MixL& P, size_t rowbase, int h, int c, int tid, int wave) {
    const int tc = tid & 255, cg = tc & 7, tp = tc >> 3;
    const bf16_t* pr = P.proj + (rowbase + c * 64 + 2 * tp) * PL + 64 * h + 8 * cg;
    __builtin_amdgcn_global_load_lds((const unsigned*)(pr + 1280), (LAS unsigned*)(lds + HG_STG + 0 * 8192 + wave * 1024), 16, 0, 0);
    __builtin_amdgcn_global_load_lds((const unsigned*)(pr + PL + 1280), (LAS unsigned*)(lds + HG_STG + 1 * 8192 + wave * 1024), 16, 0, 0);
    __builtin_amdgcn_global_load_lds((const unsigned*)(pr + 1792), (LAS unsigned*)(lds + HG_STG + 2 * 8192 + wave * 1024), 16, 0, 0);
    __builtin_amdgcn_global_load_lds((const unsigned*)(pr + PL + 1792), (LAS unsigned*)(lds + HG_STG + 3 * 8192 + wave * 1024), 16, 0, 0);
    __builtin_amdgcn_global_load_lds((const unsigned*)(pr + 2304), (LAS unsigned*)(lds + HG_STG + 4 * 8192 + wave * 1024), 16, 0, 0);
    __builtin_amdgcn_global_load_lds((const unsigned*)(pr + PL + 2304), (LAS unsigned*)(lds + HG_STG + 5 * 8192 + wave * 1024), 16, 0, 0);
}
DI void hg_unit(LAS unsigned char* lds, const MixL& P, int pi) {
    int tid_l = threadIdx.x; asm volatile("" : "+v"(tid_l));
    const int tid = tid_l, lane = tid & 63, wave = __builtin_amdgcn_readfirstlane(tid >> 6), l15 = lane & 15, q = lane >> 4;
    const int chain = wave >> 2, wv = wave & 3, ci = 2 * pi + chain, b = ci >> 3, h = ci & 7;
    LAS unsigned char* base = lds + chain * 40960;
    LAS unsigned char* QE = base; LAS unsigned char* KE = base + 9216; LAS unsigned char* KET = base + 18432; LAS unsigned char* VT = base + 27648;
    LAS float* EBREF = (LAS float*)(base + 36864); LAS float* EBLR = EBREF + 64; LAS float* EBLAST = EBREF + 128; LAS float* CUMQ = EBREF + 192; LAS float* SSQP = EBREF + 448;
    const int d = lane, tq = wv;
    const float lb = P.lb[64 * h + d], oml = 1.0f - lb;
    const size_t rowbase = (size_t)b * SEQ;
    const int ycol = 64 * h + 16 * wv + 4 * q;
    f32x4 SD[4];
#pragma unroll
    for (int i = 0; i < 4; ++i) SD[i] = (f32x4){0.f, 0.f, 0.f, 0.f};
    const f32x4 nw = *(const f32x4*)(P.hg_nw + 16 * wv + 4 * q);
    hg_dma(lds, P, rowbase, h, 0, tid, wave);
#pragma unroll 1
    for (int c = 0; c < SEQ / 64; ++c) {
        const int t0 = c * 64;
        asm volatile("s_waitcnt vmcnt(0)" ::: "memory"); __syncthreads();
        float qv[16], kv[16], cs[16]; unsigned vv[8]; float runs = 0.f;
#pragma unroll
        for (int i = 0; i < 16; ++i) { const LAS unsigned char* sp = lds + HG_STG + (i & 1) * 8192 + (chain * 256 + (8 * tq + (i >> 1)) * 8 + (d >> 3)) * 16 + (d & 7) * 2;
            const float a = bf2f(*(const LAS unsigned short*)(sp + 2 * 8192)), qr = bf2f(*(const LAS unsigned short*)sp); const unsigned vb = *(const LAS unsigned short*)(sp + 4 * 8192);
            if (i & 1) vv[i >> 1] |= vb << 16; else vv[i >> 1] = vb;
            const float e = fminf(__expf(-a), 1e30f), sg = __builtin_amdgcn_rcpf(1.0f + e);
            const float f = lb + oml * sg;
            runs += __logf(f); cs[i] = runs; qv[i] = qr; kv[i] = oml * (e * sg); }
        CUMQ[tq * 64 + d] = runs;
        __syncthreads();
        { const float c0 = CUMQ[d], c1 = CUMQ[64 + d], c2 = CUMQ[128 + d], c3 = CUMQ[192 + d];
          const float bref = c0 + c1, blast = bref + (c2 + c3);
          const float pre = (tq == 0) ? 0.f : (tq == 1 ? c0 : (tq == 2 ? bref : bref + c2));
          unsigned kt[8];
#pragma unroll
          for (int i = 0; i < 16; i += 2) { const float b0 = pre + cs[i], b1 = pre + cs[i + 1];
              const unsigned qp = pk2(qv[i] * __expf(b0 - bref), qv[i + 1] * __expf(b1 - bref)), kp = pk2(kv[i] * __expf(bref - b0), kv[i + 1] * __expf(bref - b1));
              *(LAS unsigned short*)(QE + (16 * tq + i) * LS + d * 2) = (unsigned short)(qp & 0xffffu); *(LAS unsigned short*)(QE + (16 * tq + i + 1) * LS + d * 2) = (unsigned short)(qp >> 16);
              *(LAS unsigned short*)(KE + (16 * tq + i) * LS + d * 2) = (unsigned short)(kp & 0xffffu); *(LAS unsigned short*)(KE + (16 * tq + i + 1) * LS + d * 2) = (unsigned short)(kp >> 16);
              kt[i >> 1] = kp; }
          *(LAS u32x4*)(KET + d * LS + tq * 32) = (u32x4){kt[0], kt[1], kt[2], kt[3]}; *(LAS u32x4*)(KET + d * LS + tq * 32 + 16) = (u32x4){kt[4], kt[5], kt[6], kt[7]};
          *(LAS u32x4*)(VT + d * LS + tq * 32) = (u32x4){vv[0], vv[1], vv[2], vv[3]}; *(LAS u32x4*)(VT + d * LS + tq * 32 + 16) = (u32x4){vv[4], vv[5], vv[6], vv[7]};
          if (tq == 0) { EBREF[d] = __expf(bref); EBLR[d] = __expf(blast - bref); EBLAST[d] = __expf(blast); } }
        __syncthreads();
        u32x2 gr[4];
#pragma unroll
        for (int ti = 0; ti < 4; ++ti) gr[ti] = *(const u32x2*)(P.proj + (rowbase + t0 + 16 * ti + l15) * PL + 2816 + ycol);
        if (c + 1 < SEQ / 64) hg_dma(lds, P, rowbase, h, c + 1, tid, wave);
        bf16x8 kep[4][2], qep[4][2], vtp[2];
#pragma unroll
        for (int i = 0; i < 4; ++i)
#pragma unroll
            for (int kk = 0; kk < 2; ++kk) { kep[i][kk] = ld_perm(KE, 16 * i + l15, kk, q); qep[i][kk] = ld_perm(QE, 16 * i + l15, kk, q); }
#pragma unroll
        for (int kk = 0; kk < 2; ++kk) vtp[kk] = ld_perm(VT, 16 * wv + l15, kk, q);
        f32x4 o[4];
#pragma unroll
        for (int ti = 0; ti < 4; ++ti) {
            f32x4 pt_[4];
#pragma unroll
            for (int sj = 0; sj < 4; ++sj) {
                if (sj <= ti) { f32x4 a = (f32x4){0.f, 0.f, 0.f, 0.f}; a = mma(kep[sj][0], qep[ti][0], a); a = mma(kep[sj][1], qep[ti][1], a);
                    if (sj == ti) {
#pragma unroll
                        for (int rr = 0; rr < 4; ++rr) a[rr] = (4 * q + rr <= l15) ? a[rr] : 0.f; }
                    pt_[sj] = a;
                } else pt_[sj] = (f32x4){0.f, 0.f, 0.f, 0.f};
            }
            const bf16x8 pf0 = pack8(pt_[0], pt_[1]), pf1 = pack8(pt_[2], pt_[3]);
            f32x4 a = (f32x4){0.f, 0.f, 0.f, 0.f}; a = mma(vtp[0], pf0, a); if (ti >= 2) a = mma(vtp[1], pf1, a); o[ti] = a;
        }
        { f32x4 er[4];
#pragma unroll
          for (int dj = 0; dj < 4; ++dj) er[dj] = *(const LAS f32x4*)(EBREF + 16 * dj + 4 * q);
          const bf16x8 sf0 = pack8(SD[0] * er[0], SD[1] * er[1]), sf1 = pack8(SD[2] * er[2], SD[3] * er[3]);
#pragma unroll
          for (int ti = 0; ti < 4; ++ti) { o[ti] = mma(sf0, qep[ti][0], o[ti]); o[ti] = mma(sf1, qep[ti][1], o[ti]); } }
#pragma unroll
        for (int dj = 0; dj < 4; ++dj) { f32x4 a = (f32x4){0.f, 0.f, 0.f, 0.f};
            a = mma(ld_perm(KET, 16 * dj + l15, 0, q), vtp[0], a); a = mma(ld_perm(KET, 16 * dj + l15, 1, q), vtp[1], a);
            const f32x4 el = *(const LAS f32x4*)(EBLAST + 16 * dj + 4 * q), elr = *(const LAS f32x4*)(EBLR + 16 * dj + 4 * q);
            SD[dj] = SD[dj] * el + a * elr; }
#pragma unroll
        for (int ti = 0; ti < 4; ++ti) { const f32x4 v = o[ti]; float s = (v[0] * v[0] + v[1] * v[1]) + (v[2] * v[2] + v[3] * v[3]); s += __shfl_xor(s, 16); s += __shfl_xor(s, 32);
            if (q == 0) SSQP[wv * 64 + 16 * ti + l15] = s; }
        asm volatile("s_waitcnt lgkmcnt(0)" ::: "memory"); __builtin_amdgcn_s_barrier(); asm volatile("" ::: "memory");
#pragma unroll
        for (int ti = 0; ti < 4; ++ti) { const float tot = (SSQP[16 * ti + l15] + SSQP[64 + 16 * ti + l15]) + (SSQP[128 + 16 * ti + l15] + SSQP[192 + 16 * ti + l15]);
            const float rs = __builtin_amdgcn_rsqf(tot * (1.0f / 64.0f) + pg8::RMS_EPS); const u32x2 gg = gr[ti];
            const float g0 = __uint_as_float(gg.x << 16), g1 = __uint_as_float(gg.x & 0xffff0000u), g2 = __uint_as_float(gg.y << 16), g3 = __uint_as_float(gg.y & 0xffff0000u);
            f32x4 ov = o[ti] * rs * nw; ov[0] *= g0; ov[1] *= g1; ov[2] *= g2; ov[3] *= g3;
            u32x2 w2; w2.x = pk2(ov[0], ov[1]); w2.y = pk2(ov[2], ov[3]);
            *(u32x2*)(P.Y + (rowbase + t0 + 16 * ti + l15) * D + 512 + ycol) = w2; }
    }
}


DI void prep_ssd(const MixL& P, int b, int c) {
    int tid_l = threadIdx.x; asm volatile("" : "+v"(tid_l));
    const int tid = tid_l, lane = tid & 63, wave = __builtin_amdgcn_readfirstlane(tid >> 6);
    const size_t rowbase = (size_t)b * SEQ; const int t0 = c * 64;
    if (tid < 480) {
        const int cgi = tid % 96, r5 = tid / 96, c0 = 8 * cgi;
        float w[4][8], bias[8];
#pragma unroll
        for (int k = 0; k < 4; ++k) { const f32x4 w0 = *(const f32x4*)(P.conv_w + k * 768 + c0), w1 = *(const f32x4*)(P.conv_w + k * 768 + c0 + 4);
            w[k][0] = w0[0]; w[k][1] = w0[1]; w[k][2] = w0[2]; w[k][3] = w0[3]; w[k][4] = w1[0]; w[k][5] = w1[1]; w[k][6] = w1[2]; w[k][7] = w1[3]; }
        { const f32x4 b0 = *(const f32x4*)(P.conv_b + c0), b1 = *(const f32x4*)(P.conv_b + c0 + 4);
          bias[0] = b0[0]; bias[1] = b0[1]; bias[2] = b0[2]; bias[3] = b0[3]; bias[4] = b1[0]; bias[5] = b1[1]; bias[6] = b1[2]; bias[7] = b1[3]; }
        const bf16_t* src = P.proj + rowbase * PL + 512 + c0;
        u32x4 nxt[7];
#pragma unroll
        for (int i = 0; i < 7; ++i) { const int tok = t0 + 4 * r5 - 3 + i; nxt[i] = (tok >= 0) ? *(const u32x4*)(src + (size_t)tok * PL) : (u32x4){0u, 0u, 0u, 0u}; }
#pragma unroll 1
        for (int run = r5; run < 16; run += 5) {
            u32x4 raw[7];
#pragma unroll
            for (int i = 0; i < 7; ++i) raw[i] = nxt[i];
            if (run + 5 < 16) {
#pragma unroll
                for (int i = 0; i < 7; ++i) nxt[i] = *(const u32x4*)(src + (size_t)(t0 + 4 * (run + 5) - 3 + i) * PL); }
            u32x4 rv[4];
#pragma unroll
            for (int jp = 0; jp < 2; ++jp) {
                float v0[8], v1[8];
#pragma unroll
                for (int e = 0; e < 8; ++e) { float a0 = bias[e], a1 = bias[e];
#pragma unroll
                    for (int k = 0; k < 4; ++k) {
                        const unsigned d0 = raw[2 * jp + k][e >> 1], d1 = raw[2 * jp + 1 + k][e >> 1];
                        const float f0 = (e & 1) ? __uint_as_float(d0 & 0xffff0000u) : __uint_as_float(d0 << 16);
                        const float f1 = (e & 1) ? __uint_as_float(d1 & 0xffff0000u) : __uint_as_float(d1 << 16);
                        a0 += w[k][e] * f0; a1 += w[k][e] * f1; }
                    v0[e] = silu_f(a0); v1[e] = silu_f(a1); }
#pragma unroll
                for (int e2 = 0; e2 < 4; ++e2) { rv[2 * jp][e2] = pk2(v0[2 * e2], v0[2 * e2 + 1]); rv[2 * jp + 1][e2] = pk2(v1[2 * e2], v1[2 * e2 + 1]); }
            }
#pragma unroll
            for (int j = 0; j < 4; ++j) *(u32x4*)(P.XA + (rowbase + t0 + 4 * run + j) * 768 + c0) = rv[j];
        }
    }
    {
        float* dta = P.DTA + (size_t)(b * 32 + c) * 2048; const int hd = wave;
        const float x = bf2f(P.proj[(rowbase + t0 + lane) * PL + 3328 + hd]) + P.dt_bias[hd];
        const float dt = (x > 20.f) ? x : log1pf(__expf(x));
        float a = dt * (-__expf(P.a_log[hd]));
#pragma unroll
        for (int o = 1; o < 64; o <<= 1) { const float v = __shfl_up(a, o); if (lane >= o) a += v; }
        const float aend = __shfl(a, 63);
        dta[hd * 64 + lane] = a; dta[512 + hd * 64 + lane] = dt; dta[1024 + hd * 64 + lane] = __expf(a); dta[1536 + hd * 64 + lane] = dt * __expf(aend - a);
    }
}

__global__ void __launch_bounds__(NTHR, 2) hymba_fwd(Args a) {
    extern __shared__ __attribute__((aligned(16))) unsigned char lds_raw[];
    LAS unsigned char* lds = (LAS unsigned char*)lds_raw;
    cg::grid_group grid = cg::this_grid();
#define GSYNC0() do { asm volatile("s_waitcnt vmcnt(0) lgkmcnt(0)" ::: "memory"); grid.sync(); __builtin_amdgcn_fence(__ATOMIC_ACQUIRE, "agent"); asm volatile("s_waitcnt vmcnt(0)" ::: "memory"); } while (0)
#define GSYNC() do { XcdBarrier b_; b_.bar = (unsigned*)a.ws; b_.x = xb_xcc_id(); b_.st = (volatile LAS unsigned*)(lds + MISC_OFF) + 8; xcd_barrier(b_); } while (0)
    const int tid = threadIdx.x, lane = tid & 63, wave = __builtin_amdgcn_readfirstlane(tid >> 6);
    const int G = gridDim.x, gw = blockIdx.x * NWAVES + wave, NGW = G * NWAVES;
    unsigned char* ws = a.ws;
    float* ssq = (float*)(ws + WS_SSQ);
    bf16_t* XB = (bf16_t*)(ws + WS_XB); bf16_t* YB = (bf16_t*)(ws + WS_Y); bf16_t* RB = (bf16_t*)(ws + WS_R);
    float* out = a.out;

    { volatile LAS unsigned* MISC = (volatile LAS unsigned*)(lds + MISC_OFF); if (tid < 64) MISC[tid] = 0u; }
    __syncthreads();
    (void)xcd_barrier_post((unsigned*)ws, (volatile LAS unsigned*)(lds + MISC_OFF) + 8);
    prologue(a, lds, gw, NGW, lane, wave);
    GSYNC0();

#pragma unroll 1
    for (int ph = 0; ph < DEPTH * 8; ++ph) {
        const int l = ph >> 3, k = ph & 7;
        unsigned char* wl = ws + WS_W + (size_t)l * W_LAYER;
        if (k == 0 || k == 6) {
#ifndef NO_GU
            pg8::Gemm g{XB, (const bf16_t*)(wl + (k == 0 ? W_GU1 : W_GU2)), M, NGU, D}; pg8::StaticOrder S; S.init(M, NGU, G, (int)blockIdx.x);
            pg8::EpiGU E{RB, ssq + (size_t)(3 * l + (k == 0 ? 0 : 2)) * M * 16, FF, lds + RSC_OFF + tid * 32, -1};
            pg8::gemm_phase<pg8::EpiGU, pg8::StaticOrder, true, true>(lds, g, S, E);
#endif
        } else if (k == 1 || k == 5 || k == 7) {
#ifndef NO_RES
            const int KK = (k == 5) ? D : FF;
            pg8::Gemm g{k == 5 ? YB : RB, (const bf16_t*)(wl + (k == 1 ? W_D1 : (k == 5 ? W_OUT : W_D2))), M, D, KK}; pg8::RevOrder S; S.init(M, D, G, (int)blockIdx.x);
            pg8::EpiRes E{XB, ssq + (size_t)(3 * l + (k == 1 ? 1 : (k == 5 ? 2 : 3))) * M * 16, k == 5 ? 1.0f : 0.5f};
            pg8::gemm_phase<pg8::EpiRes, pg8::RevOrder, true, true>(lds, g, S, E);
#endif
        } else if (k == 2) {
#ifndef NO_PROJ
            pg8::Gemm g{XB, (const bf16_t*)(wl + W_IN), M, PL, D}; pg8::StaticOrder S; S.init(M, PL, G, (int)blockIdx.x);
            pg8::EpiProj E{RB, ssq + (size_t)(3 * l + 1) * M * 16, PL, lds + RSC_OFF + tid * 32, -1};
            pg8::gemm_phase<pg8::EpiProj, pg8::StaticOrder, true, true>(lds, g, S, E);
#endif
        } else {
            MixL P{RB, YB, (bf16_t*)out  , (float*)(ws + WS_DTA), (float*)(ws + WS_EBV), a.in[7] + (size_t)l * 4 * 768, a.in[8] + (size_t)l * 768, a.in[9] + l * 8, a.in[10] + l * 8, a.in[11] + l * 8, a.in[12] + l * 512,
                   (const float*)(ws + WS_LB) + l * 512, a.in[14] + l * 64};
            if (k == 3) {
                for (int u = blockIdx.x; u < 1024; u += G) prep_ssd(P, u >> 5, u & 31);
            } else {
                if (l + 1 < DEPTH && (G <= 192 || (int)blockIdx.x >= 192)) {
                    const int cb = G > 192 ? (int)blockIdx.x - 192 : (int)blockIdx.x, cn = G > 192 ? G - 192 : G;
                    convert_layer(a, l + 1, lds, cb * NWAVES + wave, cn * NWAVES, lane, wave); __syncthreads(); }
                for (int u = blockIdx.x; u < 192; u += G) {
#ifndef NO_SSD
                    if (u < 64) ssd_unit(lds, P, u >> 1, u & 1);
#endif
#ifndef NO_HG
                    if (u >= 64) hg_unit(lds, P, u - 64);
#endif
                    __syncthreads(); }
            }
        }
        GSYNC();
    }
    { const float* fn = a.in[20]; const float* sq = ssq + (size_t)12 * M * 16;
      for (int m = gw; m < M; m += NGW) { const float rs = pg8::row_rs(sq, (unsigned)m);
          const u32x4* xr = (const u32x4*)(XB + (size_t)m * D); f32x4* orow = (f32x4*)(out + (size_t)m * D);
#pragma unroll
          for (int hlf = 0; hlf < 2; ++hlf) { const u32x4 bv = xr[64 * hlf + lane]; const f32x4 w0 = ((const f32x4*)fn)[2 * (64 * hlf + lane)], w1 = ((const f32x4*)fn)[2 * (64 * hlf + lane) + 1];
              const f32x4 b0 = {__uint_as_float(bv.x << 16), __uint_as_float(bv.x & 0xffff0000u), __uint_as_float(bv.y << 16), __uint_as_float(bv.y & 0xffff0000u)};
              const f32x4 b1 = {__uint_as_float(bv.z << 16), __uint_as_float(bv.z & 0xffff0000u), __uint_as_float(bv.w << 16), __uint_as_float(bv.w & 0xffff0000u)};
              orow[2 * (64 * hlf + lane)] = b0 * rs * w0; orow[2 * (64 * hlf + lane) + 1] = b1 * rs * w1; } } }
}

extern "C" void kernel_launch(void* const* d_in, const int* in_sizes, int n_in, void* d_out, int out_size, void* d_ws, size_t ws_size, hipStream_t stream) {
    static int grid = 0;
    if (grid == 0) {
        if (n_in != 21 || in_sizes[0] != M * D || out_size != M * D || ws_size < WS_END) { fprintf(stderr, "kernel_launch: unexpected shapes (n_in %d, in0 %d, out %d, ws %zu); nothing launched\n", n_in, n_in > 0 ? in_sizes[0] : -1, out_size, ws_size); grid = -1; return; }
        int dev = 0, cus = 0, per_cu = 0;
        if (hipGetDevice(&dev) != hipSuccess || hipDeviceGetAttribute(&cus, hipDeviceAttributeMultiprocessorCount, dev) != hipSuccess) { fprintf(stderr, "kernel_launch: device query failed\n"); grid = -1; return; }
        if (hipFuncSetAttribute((const void*)hymba_fwd, hipFuncAttributeMaxDynamicSharedMemorySize, LDS_BYTES) != hipSuccess) { fprintf(stderr, "kernel_launch: hipFuncSetAttribute failed\n"); grid = -1; return; }
        if (hipOccupancyMaxActiveBlocksPerMultiprocessor(&per_cu, (const void*)hymba_fwd, NTHR, LDS_BYTES) != hipSuccess || per_cu < 1) { fprintf(stderr, "kernel_launch: occupancy query gave %d\n", per_cu); per_cu = 1; }
        (void)hipGetLastError();
        grid = cus;
    }
    if (grid < 0) return;
    if (hipMemsetAsync(d_ws, 0, 16384, stream) != hipSuccess) { fprintf(stderr, "kernel_launch: hipMemsetAsync failed\n"); return; }
    Args a{};
    for (int i = 0; i < 21; ++i) a.in[i] = (const float*)d_in[i];
    a.out = (float*)d_out; a.ws = (unsigned char*)d_ws;
    void* args[] = {&a};
    const hipError_t e = hipLaunchCooperativeKernel((const void*)hymba_fwd, dim3(grid), dim3(NTHR), args, LDS_BYTES, stream);
    if (e != hipSuccess) fprintf(stderr, "kernel_launch: cooperative launch failed: %s (grid %d)\n", hipGetErrorString(e), grid);
}
```

```cpp
#include <hip/hip_runtime.h>
#include <hip/hip_cooperative_groups.h>
#include <cstdio>
#include <cstdint>
namespace cg = cooperative_groups;

namespace pg8 {
#define PG8_LAS __attribute__((address_space(3)))
typedef unsigned short bf16_t;
typedef short bf16x8 __attribute__((ext_vector_type(8)));
typedef float f32x4 __attribute__((ext_vector_type(4)));
typedef unsigned u32x4 __attribute__((ext_vector_type(4)));
constexpr int BM = 256, BK = 64, HALF = 128, HTB = HALF * BK * 2  , STAGE_BYTES = 8 * HTB, NXCD = 8, WGM = 8;

__host__ __device__ __forceinline__ int lds_byte(int r, int c) { const int st = (r >> 4) * 2 + (c >> 5), rr = r & 15, cc = c & 31, ob = rr * 64 + cc * 2; return st * 1024 + (ob ^ (((ob >> 9) & 1) << 5)); }
__host__ __device__ __forceinline__ void stage_rc(int b, int& R, int& C) { const int st = b / 1024, sb = b % 1024, swz = sb ^ (((sb >> 9) & 1) << 5); R = (st >> 1) * 16 + swz / 64; C = (st & 1) * 32 + (swz % 64) / 2; }
__host__ __device__ __forceinline__ int perm32(int rho) { const int n = rho >> 4, i = rho & 15; return 8 * (i >> 2) + 4 * n + (i & 3); }

struct Unit { int pm, pn; };
struct Gemm { const bf16_t* A; const bf16_t* Bt; int M, N, K; };

struct StaticOrder {
    int nM, nN, nwg, G, c;
    __host__ __device__ void init(int M, int N, int G_, int c_) { nM = M / BM; nN = N / BM; nwg = nM * nN; G = G_; c = c_; }
    __host__ __device__ bool next(int i, Unit& u) const {
        const long L = (long)i * G + c; if (L >= nwg) return false;
        int wgid = (int)L; const int xcd_ = wgid % NXCD; { const int q = nwg / NXCD, r = nwg % NXCD, xcd = wgid % NXCD, off = wgid / NXCD; wgid = (xcd < r ? xcd * (q + 1) : r * (q + 1) + (xcd - r) * q) + off; }
        const int nig = WGM * nN, gid = wgid / nig, fm = gid * WGM, gsz = (nM - fm) < WGM ? (nM - fm) : WGM;
        u.pm = fm + ((wgid % nig) % gsz); u.pn = ((wgid % nig) / gsz + (xcd_ * nN) / NXCD) % nN;
        return true;
    }
    __device__ __forceinline__ void a_ready(const Unit&) const {}
    __device__ __forceinline__ void done(const Unit&) const {}
};


typedef __bf16 bf16x2n __attribute__((ext_vector_type(2)));
typedef float f32x2n __attribute__((ext_vector_type(2)));
__device__ __forceinline__ unsigned pk2(float lo, float hi) { f32x2n v = {lo, hi}; bf16x2n b = __builtin_convertvector(v, bf16x2n); return __builtin_bit_cast(unsigned, b); }
__device__ __forceinline__ float silu_f(float x) { return x * __builtin_amdgcn_rcpf(1.0f + __expf(-x)); }

struct RevOrder : StaticOrder {
    __host__ __device__ bool next(int i, Unit& u) const { if (nwg % G != 0) return StaticOrder::next(i, u);
        const int nr = nwg / G; if (i >= nr) return false; return StaticOrder::next(nr - 1 - i, u); }
};
constexpr float RMS_EPS = 1e-6f;
__device__ __forceinline__ float row_rs(const float* ssq, unsigned row) {
    const f32x4* sp = (const f32x4*)(ssq + (size_t)row * 16); const f32x4 a = (sp[0] + sp[1]) + (sp[2] + sp[3]);
    return __builtin_amdgcn_rsqf(((a[0] + a[1]) + (a[2] + a[3])) * (1.0f / 1024.0f) + RMS_EPS);
}
#define PG8_RS8(ssq_, u_, row0_, rsv_, slot_, last_pm_) do { \
    if ((u_).pm != (last_pm_)) { _Pragma("unroll") for (int i_ = 0; i_ < 8; ++i_) (rsv_)[i_] = row_rs((ssq_), (row0_) + (i_ >> 2) * HALF + (i_ & 3) * 16); \
        *(PG8_LAS f32x4*)(slot_) = (f32x4){(rsv_)[0], (rsv_)[1], (rsv_)[2], (rsv_)[3]}; *(PG8_LAS f32x4*)((slot_) + 16) = (f32x4){(rsv_)[4], (rsv_)[5], (rsv_)[6], (rsv_)[7]}; (last_pm_) = (u_).pm; } \
    else { const f32x4 a_ = *(const PG8_LAS f32x4*)(slot_), b_ = *(const PG8_LAS f32x4*)((slot_) + 16); \
        (rsv_)[0] = a_[0]; (rsv_)[1] = a_[1]; (rsv_)[2] = a_[2]; (rsv_)[3] = a_[3]; (rsv_)[4] = b_[0]; (rsv_)[5] = b_[1]; (rsv_)[6] = b_[2]; (rsv_)[7] = b_[3]; } } while (0)
struct EpiGU {
    static constexpr bool PERM = true, AFTER_DRAIN = false;
    bf16_t* H; const float* ssq; int ldh; PG8_LAS unsigned char* slot; mutable int last_pm;
    __device__ __forceinline__ void operator()(const f32x4 (&acc)[2][2][4][2], const Unit& u, int wr, int wc, int fr, int fq) const {
        const int row0 = u.pm * BM + wr * 64 + fr, col0 = u.pn * HALF + wc * 32 + 8 * fq;
        float rsv[8]; PG8_RS8(ssq, u, row0, rsv, slot, last_pm);
#pragma unroll
        for (int ai = 0; ai < 2; ++ai)
#pragma unroll
            for (int m = 0; m < 4; ++m) { const int row = row0 + ai * HALF + m * 16; const float rs = rsv[ai * 4 + m];
                u32x4 w; unsigned wv[4];
#pragma unroll
                for (int n = 0; n < 2; ++n) { const f32x4 g = acc[ai][0][m][n] * rs, up = acc[ai][1][m][n] * rs;
                    const float h0 = silu_f(g[0]) * up[0], h1 = silu_f(g[1]) * up[1], h2 = silu_f(g[2]) * up[2], h3 = silu_f(g[3]) * up[3];
                    wv[2 * n] = pk2(h0, h1); wv[2 * n + 1] = pk2(h2, h3); }
                w.x = wv[0]; w.y = wv[1]; w.z = wv[2]; w.w = wv[3];
                *(u32x4*)(H + (size_t)row * ldh + col0) = w; }
    }
};
struct EpiRes {
    static constexpr bool PERM = true, AFTER_DRAIN = false;
    bf16_t* xb; float* ssq_out; float scale;
    __device__ __forceinline__ void operator()(const f32x4 (&acc)[2][2][4][2], const Unit& u, int wr, int wc, int fr, int fq) const {
        const unsigned row0 = u.pm * BM + wr * 64 + fr, col0 = u.pn * BM + wc * 32 + 8 * fq;
#pragma unroll
        for (int ai = 0; ai < 2; ++ai)
#pragma unroll
            for (int m = 0; m < 4; ++m) { const unsigned row = row0 + ai * HALF + m * 16; const unsigned off = row * 1024u + col0; float s = 0.f;
                const u32x4 bv0 = *(const u32x4*)(xb + off), bv1 = *(const u32x4*)(xb + off + HALF);
#pragma unroll
                for (int bj = 0; bj < 2; ++bj) { const u32x4 bv = bj ? bv1 : bv0;
                    const f32x4 b0 = {__uint_as_float(bv.x << 16), __uint_as_float(bv.x & 0xffff0000u), __uint_as_float(bv.y << 16), __uint_as_float(bv.y & 0xffff0000u)};
                    const f32x4 b1 = {__uint_as_float(bv.z << 16), __uint_as_float(bv.z & 0xffff0000u), __uint_as_float(bv.w << 16), __uint_as_float(bv.w & 0xffff0000u)};
                    const f32x4 v0 = b0 + acc[ai][bj][m][0] * scale, v1 = b1 + acc[ai][bj][m][1] * scale;
                    u32x4 w; w.x = pk2(v0[0], v0[1]); w.y = pk2(v0[2], v0[3]); w.z = pk2(v1[0], v1[1]); w.w = pk2(v1[2], v1[3]);
                    *(u32x4*)(xb + off + bj * HALF) = w;
                    s += (v0[0] * v0[0] + v0[1] * v0[1]) + (v0[2] * v0[2] + v0[3] * v0[3]) + (v1[0] * v1[0] + v1[1] * v1[1]) + (v1[2] * v1[2] + v1[3] * v1[3]); }
                s += __shfl_xor(s, 16); s += __shfl_xor(s, 32);
                if (fq == 0) ssq_out[(size_t)row * 16 + u.pn * 4 + wc] = s;
                asm volatile("" ::: "memory"); }
    }
};
struct EpiProj {
    static constexpr bool PERM = true, AFTER_DRAIN = false;
    bf16_t* P; const float* ssq; int ldp; PG8_LAS unsigned char* slot; const float* lb; mutable int last_pm;
    __device__ __forceinline__ void operator()(const f32x4 (&acc)[2][2][4][2], const Unit& u, int wr, int wc, int fr, int fq) const {
        const int row0 = u.pm * BM + wr * 64 + fr, col0 = u.pn * BM + wc * 32 + 8 * fq;
        float rsv[8]; PG8_RS8(ssq, u, row0, rsv, slot, last_pm);
        const bool fgate = (u.pn == 7) || (u.pn == 8);
        f32x4 lbv[2][2];
        if (fgate) {
#pragma unroll
            for (int bj = 0; bj < 2; ++bj) { lbv[bj][0] = *(const f32x4*)(lb + col0 - 1792 + bj * HALF); lbv[bj][1] = *(const f32x4*)(lb + col0 - 1792 + bj * HALF + 4); } }
        const bool act = (u.pn < 2) || (u.pn == 5) || (u.pn == 6) || (u.pn == 11) || (u.pn == 12);
#pragma unroll
        for (int ai = 0; ai < 2; ++ai)
#pragma unroll
            for (int m = 0; m < 4; ++m) { const int row = row0 + ai * HALF + m * 16; const float rs = rsv[ai * 4 + m];
                bf16_t* rowp = P + (size_t)row * ldp + col0;
#pragma unroll
                for (int bj = 0; bj < 2; ++bj) { f32x4 v0 = acc[ai][bj][m][0] * rs, v1 = acc[ai][bj][m][1] * rs;
                    if (act) {
#pragma unroll
                        for (int j = 0; j < 4; ++j) { v0[j] = silu_f(v0[j]); v1[j] = silu_f(v1[j]); } }
                    if (fgate) {
#pragma unroll
                        for (int j = 0; j < 4; ++j) {
                            const float e0 = fminf(__expf(-v0[j]), 1e30f), s0 = __builtin_amdgcn_rcpf(1.0f + e0), e1 = fminf(__expf(-v1[j]), 1e30f), s1 = __builtin_amdgcn_rcpf(1.0f + e1);
                            v0[j] = __logf(lbv[bj][0][j] + (1.0f - lbv[bj][0][j]) * s0); v1[j] = __logf(lbv[bj][1][j] + (1.0f - lbv[bj][1][j]) * s1); } }
                    u32x4 w; w.x = pk2(v0[0], v0[1]); w.y = pk2(v0[2], v0[3]); w.z = pk2(v1[0], v1[1]); w.w = pk2(v1[2], v1[3]);
                    *(u32x4*)(rowp + bj * HALF) = w; } }
    }
};

template <class Epi, class Sched, bool ALIGN_EPI = false, bool SP2 = false>
__device__ __forceinline__ void gemm_phase(PG8_LAS unsigned char* lds, const Gemm g, const Sched& S, const Epi& E) {
    int tid_l = threadIdx.x; asm volatile("" : "+v"(tid_l));
    const int tid = tid_l, wid = __builtin_amdgcn_readfirstlane(tid >> 6), lane = tid & 63, wr = wid >> 2, wc = wid & 3, fr = lane & 15, fq = lane >> 4;
    const int K = g.K, nt = K / BK;
    unsigned voffA[2], voffB[2];
#pragma unroll
    for (int i = 0; i < 2; ++i) { int R, C; stage_rc(tid * 16 + i * 8192, R, C); const int Rb = Epi::PERM ? ((R & ~31) + perm32(R & 31)) : R;
        voffA[i] = (unsigned)(R * K + C) * 2u; voffB[i] = (unsigned)(Rb * K + C) * 2u; }
    const size_t kstep = (size_t)(BK * 2);
    const size_t hstep = (size_t)HALF * K * 2;
    const size_t tstep = 2 * hstep;
    const unsigned ldsw = (unsigned)wid * 1024u;
    const int aoff = lds_byte(wr * 64 + fr, fq * 8), boff = lds_byte(wc * 32 + fr, fq * 8);
#define PG8_SA(b, h) (((b) * 2 + (h)) * HTB)
#define PG8_SB(b, h) ((4 + (b) * 2 + (h)) * HTB)
#define PG8_STAGE(bufoff, gbase, voff) do { _Pragma("unroll") for (int _i = 0; _i < 2; ++_i) \
        __builtin_amdgcn_global_load_lds((const unsigned*)((const char*)(gbase) + (voff)[_i]), (PG8_LAS unsigned*)(lds + (bufoff) + ldsw + _i * 8192), 16, 0, 0); } while (0)
#define PG8_LDA(dst, b, h) do { _Pragma("unroll") for (int m = 0; m < 4; ++m) _Pragma("unroll") for (int k = 0; k < 2; ++k) dst[m][k] = *(const PG8_LAS bf16x8*)(lds + PG8_SA(b, h) + aoff + m * 2048 + k * 1024); } while (0)
#define PG8_LDB(dst, b, h) do { _Pragma("unroll") for (int n = 0; n < 2; ++n) _Pragma("unroll") for (int k = 0; k < 2; ++k) dst[n][k] = *(const PG8_LAS bf16x8*)(lds + PG8_SB(b, h) + boff + n * 2048 + k * 1024); } while (0)
#define PG8_MMA(ai, bj, At, Bt) do { __builtin_amdgcn_s_setprio(1); _Pragma("unroll") for (int m = 0; m < 4; ++m) _Pragma("unroll") for (int n = 0; n < 2; ++n) _Pragma("unroll") for (int k = 0; k < 2; ++k) \
        acc[ai][bj][m][n] = __builtin_amdgcn_mfma_f32_16x16x32_bf16(Bt[n][k], At[m][k], acc[ai][bj][m][n], 0, 0, 0); __builtin_amdgcn_s_setprio(0); } while (0)
#define PG8_WAIT_V(n) asm volatile("s_waitcnt vmcnt(" #n ")" ::: "memory")
#define PG8_WAIT_L(n) asm volatile("s_waitcnt lgkmcnt(" #n ")" ::: "memory")
#define PG8_BAR __builtin_amdgcn_s_barrier()
#define PG8_SCHED __builtin_amdgcn_sched_barrier(0)
    Unit cur, nxt; int ui = 0;
    if (!S.next(0, cur)) return;
    f32x4 acc[2][2][4][2];
#pragma unroll
    for (int a = 0; a < 2; ++a)
#pragma unroll
        for (int b = 0; b < 2; ++b)
#pragma unroll
            for (int m = 0; m < 4; ++m)
#pragma unroll
                for (int n = 0; n < 2; ++n) acc[a][b][m][n] = (f32x4){0.f, 0.f, 0.f, 0.f};
    bf16x8 At[4][2], B0[2][2], B1[2][2];
    const char* cA = (const char*)g.A + (size_t)cur.pm * tstep; const char* cB = (const char*)g.Bt + (size_t)cur.pn * tstep;
    S.a_ready(cur);
    if constexpr (SP2) {
        PG8_STAGE(PG8_SB(0, 0), cB, voffB); PG8_STAGE(PG8_SB(0, 1), cB + hstep, voffB); PG8_STAGE(PG8_SA(0, 0), cA, voffA); PG8_STAGE(PG8_SA(0, 1), cA + hstep, voffA);
        if (wr == 1) PG8_BAR;
        PG8_WAIT_V(2); PG8_BAR;
        PG8_STAGE(PG8_SB(1, 0), cB + kstep, voffB); PG8_STAGE(PG8_SA(1, 0), cA + kstep, voffA); PG8_STAGE(PG8_SB(1, 1), cB + hstep + kstep, voffB);
        PG8_WAIT_V(6); PG8_BAR;
    } else {
        PG8_STAGE(PG8_SB(0, 0), cB, voffB); PG8_STAGE(PG8_SA(0, 0), cA, voffA); PG8_STAGE(PG8_SB(0, 1), cB + hstep, voffB); PG8_STAGE(PG8_SA(0, 1), cA + hstep, voffA);
        if (wr == 1) PG8_BAR;
        PG8_WAIT_V(4); PG8_BAR;
        PG8_STAGE(PG8_SB(1, 0), cB + kstep, voffB); PG8_STAGE(PG8_SA(1, 0), cA + kstep, voffA); PG8_STAGE(PG8_SB(1, 1), cB + hstep + kstep, voffB);
        PG8_WAIT_V(6); PG8_BAR;
    }
    for (;;) {
        const bool has_next = S.next(ui + 1, nxt);
        const char* nA = has_next ? (const char*)g.A + (size_t)nxt.pm * tstep : cA; const char* nB = has_next ? (const char*)g.Bt + (size_t)nxt.pn * tstep : cB;
        for (int t = 0; t < nt; t += 2) {
            const bool last = (t == nt - 2);
            const char* a1 = cA + (size_t)(t + 1) * kstep;
            const char* a2 = last ? nA : cA + (size_t)(t + 2) * kstep; const char* b2 = last ? nB : cB + (size_t)(t + 2) * kstep;
            const char* a3 = a2 + kstep; const char* b3 = b2 + kstep;
            if (last && has_next) S.a_ready(nxt);
            if constexpr (SP2) {
            PG8_LDB(B0, 0, 0); PG8_LDB(B1, 0, 1); PG8_SCHED; PG8_LDA(At, 0, 0); PG8_STAGE(PG8_SA(1, 1), a1 + hstep, voffA);
            PG8_WAIT_V(8); PG8_WAIT_L(0); PG8_BAR; PG8_MMA(0, 0, At, B0); PG8_MMA(0, 1, At, B1); PG8_BAR; PG8_SCHED;
            PG8_LDA(At, 0, 1); PG8_STAGE(PG8_SB(0, 0), b2, voffB); PG8_STAGE(PG8_SB(0, 1), b2 + hstep, voffB); PG8_STAGE(PG8_SA(0, 0), a2, voffA);
            PG8_WAIT_V(8); PG8_WAIT_L(0); PG8_BAR; PG8_MMA(1, 0, At, B0); PG8_MMA(1, 1, At, B1); PG8_BAR; PG8_SCHED;
            PG8_LDB(B0, 1, 0); PG8_LDB(B1, 1, 1); PG8_SCHED; PG8_LDA(At, 1, 0); PG8_STAGE(PG8_SA(0, 1), a2 + hstep, voffA);
            PG8_WAIT_V(8); PG8_WAIT_L(0); PG8_BAR; PG8_MMA(0, 0, At, B0); PG8_MMA(0, 1, At, B1); PG8_BAR; PG8_SCHED;
            PG8_LDA(At, 1, 1); PG8_STAGE(PG8_SB(1, 0), b3, voffB); PG8_STAGE(PG8_SB(1, 1), b3 + hstep, voffB); PG8_STAGE(PG8_SA(1, 0), a3, voffA);
            PG8_WAIT_V(8); PG8_WAIT_L(0); PG8_BAR; PG8_MMA(1, 0, At, B0); PG8_MMA(1, 1, At, B1); PG8_BAR; PG8_SCHED;
            } else {
            PG8_LDB(B0, 0, 0); PG8_SCHED; PG8_LDA(At, 0, 0); PG8_STAGE(PG8_SA(1, 1), a1 + hstep, voffA);
            PG8_WAIT_L(8); PG8_BAR; PG8_WAIT_L(0); PG8_MMA(0, 0, At, B0); PG8_BAR; PG8_SCHED;
            PG8_LDB(B1, 0, 1); PG8_STAGE(PG8_SB(0, 0), b2, voffB);
            PG8_BAR; PG8_WAIT_L(0); PG8_MMA(0, 1, At, B1); PG8_BAR;
            PG8_LDA(At, 0, 1); PG8_STAGE(PG8_SA(0, 0), a2, voffA);
            PG8_BAR; PG8_WAIT_L(0); PG8_MMA(1, 0, At, B0); PG8_BAR; PG8_SCHED;
            PG8_STAGE(PG8_SB(0, 1), b2 + hstep, voffB);
            PG8_WAIT_V(6); PG8_BAR; PG8_MMA(1, 1, At, B1); PG8_BAR;
            PG8_LDB(B0, 1, 0); PG8_SCHED; PG8_LDA(At, 1, 0); PG8_STAGE(PG8_SA(0, 1), a2 + hstep, voffA);
            PG8_WAIT_L(8); PG8_BAR; PG8_WAIT_L(0); PG8_MMA(0, 0, At, B0); PG8_BAR; PG8_SCHED;
            PG8_LDB(B1, 1, 1); PG8_STAGE(PG8_SB(1, 0), b3, voffB);
            PG8_BAR; PG8_WAIT_L(0); PG8_MMA(0, 1, At, B1); PG8_BAR;
            PG8_LDA(At, 1, 1); PG8_STAGE(PG8_SA(1, 0), a3, voffA);
            PG8_BAR; PG8_WAIT_L(0); PG8_MMA(1, 0, At, B0); PG8_BAR; PG8_SCHED;
            PG8_STAGE(PG8_SB(1, 1), b3 + hstep, voffB);
            PG8_WAIT_V(6); PG8_BAR; PG8_MMA(1, 1, At, B1); PG8_BAR;
            }
        }
        if constexpr (ALIGN_EPI) { if (wr == 0) PG8_BAR; }
        if constexpr (!Epi::AFTER_DRAIN) { E(acc, cur, wr, wc, fr, fq); S.done(cur); }
        if (!has_next) break;
#pragma unroll
        for (int a = 0; a < 2; ++a)
#pragma unroll
            for (int b = 0; b < 2; ++b)
#pragma unroll
                for (int m = 0; m < 4; ++m)
#pragma unroll
                    for (int n = 0; n < 2; ++n) acc[a][b][m][n] = (f32x4){0.f, 0.f, 0.f, 0.f};
        cur = nxt; cA = nA; cB = nB; ++ui;
        if constexpr (ALIGN_EPI) { if (wr == 1) PG8_BAR; }
    }
    PG8_WAIT_V(0);
    if constexpr (!ALIGN_EPI) { if (wr == 0) PG8_BAR; }
    PG8_BAR;
    if constexpr (Epi::AFTER_DRAIN) { E.fused(acc, cur, wr, wc, fr, fq, lds, wid, lane); S.done(cur); }
#undef PG8_SA
#undef PG8_SB
#undef PG8_STAGE
#undef PG8_LDA
#undef PG8_LDB
#undef PG8_MMA
#undef PG8_WAIT_V
#undef PG8_WAIT_L
#undef PG8_BAR
#undef PG8_SCHED
}
}

#define DI __device__ __forceinline__
#define LAS __attribute__((address_space(3)))
typedef unsigned short bf16_t;
typedef short bf16x8 __attribute__((ext_vector_type(8)));
typedef short s16x4 __attribute__((ext_vector_type(4)));
typedef float f32x4 __attribute__((ext_vector_type(4)));
typedef unsigned u32x4 __attribute__((ext_vector_type(4)));
typedef unsigned u32x2 __attribute__((ext_vector_type(2)));
using pg8::pk2; using pg8::silu_f;

constexpr int NWAVES = 8, NTHR = 512;
constexpr int M = 65536, D = 1024, FF = 2816, NGU = 2 * FF, PL = 3584, SEQ = 2048, DEPTH = 4, DPROJ = 3336;
constexpr int LDS_BYTES = 131072 + 256 + 16384, MISC_OFF = 131072, RSC_OFF = 131072 + 256;
constexpr size_t MiB = 1u << 20;
constexpr size_t WS_SSQ = 880 * MiB;
constexpr size_t WS_LB = 5 * MiB;
constexpr size_t WS_W = 8 * MiB;
constexpr size_t W_GU1 = 0, W_D1 = 11 * MiB, W_IN = W_D1 + 11 * MiB / 2, W_OUT = W_IN + 7 * MiB, W_GU2 = W_OUT + 2 * MiB, W_D2 = W_GU2 + 11 * MiB, W_LAYER = 42 * MiB;
static_assert(W_D2 + 11 * MiB / 2 == W_LAYER, "weight map");
constexpr size_t WS_XB = 176 * MiB;
constexpr size_t WS_Y = 304 * MiB;
constexpr size_t WS_R = 432 * MiB;
constexpr size_t WS_DTA = 932 * MiB;
constexpr size_t WS_EBV = 948 * MiB;
constexpr size_t WS_END = 956 * MiB;
static_assert(WS_W + 4 * W_LAYER == WS_XB && WS_R + (size_t)M * PL * 2 == WS_SSQ && WS_SSQ + 13 * 4 * MiB == WS_DTA, "ws map");

DI float bf2f(unsigned short h) { return __uint_as_float((unsigned)h << 16); }
DI float wave_sum(float v) {
#pragma unroll
    for (int o = 1; o < 64; o <<= 1) v += __shfl_xor(v, o);
    return v;
}
#define LDS_WAIT() asm volatile("s_waitcnt lgkmcnt(0)" ::: "memory")
DI f32x4 mma(bf16x8 a, bf16x8 b, f32x4 c) { return __builtin_amdgcn_mfma_f32_16x16x32_bf16(a, b, c, 0, 0, 0); }
DI bf16x8 pack8(f32x4 a, f32x4 b) { u32x4 w; w.x = pk2(a[0], a[1]); w.y = pk2(a[2], a[3]); w.z = pk2(b[0], b[1]); w.w = pk2(b[2], b[3]); return __builtin_bit_cast(bf16x8, w); }
constexpr int LS = 144;
DI bf16x8 ld_perm(const LAS unsigned char* base, int row, int kk, int q) {
    const LAS unsigned char* p = base + row * LS + kk * 64 + q * 8;
    const s16x4 lo = *(const LAS s16x4*)p, hi = *(const LAS s16x4*)(p + 32);
    return __builtin_shufflevector(lo, hi, 0, 1, 2, 3, 4, 5, 6, 7);
}
DI bf16x8 scale8(bf16x8 x, f32x4 wlo, f32x4 whi) {
    const u32x4 u = __builtin_bit_cast(u32x4, x);
    f32x4 a, b;
    a[0] = __uint_as_float(u.x << 16) * wlo[0]; a[1] = __uint_as_float(u.x & 0xffff0000u) * wlo[1];
    a[2] = __uint_as_float(u.y << 16) * wlo[2]; a[3] = __uint_as_float(u.y & 0xffff0000u) * wlo[3];
    b[0] = __uint_as_float(u.z << 16) * whi[0]; b[1] = __uint_as_float(u.z & 0xffff0000u) * whi[1];
    b[2] = __uint_as_float(u.w << 16) * whi[2]; b[3] = __uint_as_float(u.w & 0xffff0000u) * whi[3];
    return pack8(a, b);
}

#define XB_TMO      128
#define XB_XCNT(j)  (256  + 64 * (j))
#define XB_XSUB(j)  (1280 + 64 * (j))
#define XB_XGEN(j)  (2304 + 64 * (j))
#define XB_TOP      3328
#define XB_TOPGEN   3392
#define XCD_BAR_WORDS 3456
#define XB_SPIN_CAP (1u << 18)

__device__ __forceinline__ unsigned xb_ld(unsigned* p)              { return __hip_atomic_load(p, __ATOMIC_RELAXED, __HIP_MEMORY_SCOPE_AGENT); }
__device__ __forceinline__ unsigned xb_add(unsigned* p, unsigned v) { return __hip_atomic_fetch_add(p, v, __ATOMIC_RELAXED, __HIP_MEMORY_SCOPE_AGENT); }
__device__ __forceinline__ unsigned xb_xcc_id() { return (unsigned)__builtin_amdgcn_s_getreg((3 << 11) | 20) & 0xFu; }
#define XB_SPIN(cond, bar) do { unsigned _sp = 0; while (cond) { __builtin_amdgcn_s_sleep(1); \
    if ((++_sp & 255u) == 0u) { if (xb_ld(&(bar)[XB_TMO])) break; if (_sp > XB_SPIN_CAP) { atomicAdd(&(bar)[XB_TMO], 1u); break; } } } } while (0)

struct XcdBarrier {
    unsigned* bar; unsigned x;
    volatile LAS unsigned* st;
};

__device__ __forceinline__ XcdBarrier xcd_barrier_post(unsigned* bar, volatile LAS unsigned* st) {
    XcdBarrier b; b.bar = bar; b.x = xb_xcc_id(); b.st = st;
    if (threadIdx.x == 0) (void)xb_add(&bar[XB_XCNT(b.x)], 1u);
    return b;
}
__device__ __forceinline__ void xcd_barrier_complete(unsigned* bar, unsigned x, unsigned& nloc, unsigned& nx) {
    const unsigned G = gridDim.x * gridDim.y * gridDim.z;
    unsigned sum, cnt, mine, sp = 0u;
    for (;;) {
        sum = 0u; cnt = 0u; mine = 0u;
#pragma unroll
        for (unsigned j = 0; j < 16; ++j) { const unsigned c = xb_ld(&bar[XB_XCNT(j)]); sum += c; cnt += (c > 0u) ? 1u : 0u; mine = (j == x) ? c : mine; }
        if (sum == G) break;
        __builtin_amdgcn_s_sleep(1);
        if ((++sp & 255u) == 0u) { if (xb_ld(&bar[XB_TMO])) break; if (sp > XB_SPIN_CAP) { atomicAdd(&bar[XB_TMO], 1u); break; } }
    }
    nloc = mine > 0u ? mine : 1u; nx = cnt > 0u ? cnt : 1u;
}

__device__ __forceinline__ void xcd_barrier(const XcdBarrier& b) {
    asm volatile("s_waitcnt vmcnt(0)" ::: "memory");
    __syncthreads();
    if (threadIdx.x == 0) {
        unsigned* bar = b.bar;
        __builtin_amdgcn_s_waitcnt(0);
        unsigned nloc = b.st[0], nx = b.st[1];
        if (nloc == 0u) { xcd_barrier_complete(bar, b.x, nloc, nx); b.st[0] = nloc; b.st[1] = nx; }
        const unsigned old = xb_add(&bar[XB_XSUB(b.x)], 1u);
        const unsigned gen = old / nloc;
        if (old + 1u == (gen + 1u) * nloc) {
            __builtin_amdgcn_fence(__ATOMIC_RELEASE, "agent");
            asm volatile("s_waitcnt vmcnt(0)" ::: "memory");
            const unsigned og = xb_add(&bar[XB_TOP], 1u);
            const unsigned tg = og / nx;
            if (og + 1u == (tg + 1u) * nx) xb_add(&bar[XB_TOPGEN], 1u);
            else XB_SPIN(xb_ld(&bar[XB_TOPGEN]) == tg, bar);
            __builtin_amdgcn_fence(__ATOMIC_ACQUIRE, "agent");
            xb_add(&bar[XB_XGEN(b.x)], 1u);
            asm volatile("s_waitcnt vmcnt(0)" ::: "memory");
        } else {
            XB_SPIN(xb_ld(&bar[XB_XGEN(b.x)]) == gen, bar);
            __builtin_amdgcn_fence(__ATOMIC_ACQUIRE, "agent");
            asm volatile("s_waitcnt vmcnt(0)" ::: "memory");
        }
    }
    __syncthreads();
}

DI void p0_item(const float* W, int ldsrc, int k0, int src_col0, int nvalid, const float* normw, bf16_t* WT, int ldk, int dst_row0, LAS float* scr, int lane) {
    const int c = lane & 31;
#pragma unroll
    for (int i = 0; i < 32; ++i) { const int kk = 2 * i + (lane >> 5);
        float v = (c < nvalid) ? W[(size_t)(k0 + kk) * ldsrc + src_col0 + c] : 0.f;
        if (normw) v *= normw[k0 + kk];
        scr[kk * 33 + c] = v; }
    LDS_WAIT(); asm volatile("" ::: "memory");
    const int c8 = lane & 7;
#pragma unroll
    for (int j = 0; j < 4; ++j) { const int n = (lane >> 3) + 8 * j; const LAS float* s = scr + (8 * c8) * 33 + n;
        u32x4 o; o.x = pk2(s[0 * 33], s[1 * 33]); o.y = pk2(s[2 * 33], s[3 * 33]); o.z = pk2(s[4 * 33], s[5 * 33]); o.w = pk2(s[6 * 33], s[7 * 33]);
        *(u32x4*)(WT + (size_t)(dst_row0 + n) * ldk + k0 + 8 * c8) = o; }
    LDS_WAIT(); asm volatile("" ::: "memory");
}

struct Args { const float* in[21]; float* out; unsigned char* ws; };

DI void convert_layer(const Args& a, int l, LAS unsigned char* lds, int gw, int NGW, int lane_in, int wave) {
    int lane = lane_in; asm volatile("" : "+v"(lane));
    unsigned char* ws = a.ws;
    LAS float* scr = (LAS float*)(lds + wave * 16384);
    constexpr int I_GU = (NGU / 32) * (D / 64), I_D = (D / 32) * (FF / 64), I_IN = (PL / 32) * (D / 64), I_OUT = (D / 32) * (D / 64);
    constexpr int I_LAYER = 2 * I_GU + 2 * I_D + I_IN + I_OUT;
    unsigned char* wl = ws + WS_W + (size_t)l * W_LAYER;
    for (int it = gw; it < I_LAYER; it += NGW) {
        int r = it;
        int which = 0;
        if (r >= I_GU) { r -= I_GU; which = 1; if (r >= I_D) { r -= I_D; which = 2; if (r >= I_IN) { r -= I_IN; which = 3; if (r >= I_OUT) { r -= I_OUT; which = 4; if (r >= I_GU) { r -= I_GU; which = 5; } } } } }
        if (which == 0 || which == 4) {
            const int nblk = NGU / 32, kb = r / nblk, nb = r % nblk, pn = nb >> 3, j = nb & 7;
            const float* src = (j < 4) ? a.in[which == 0 ? 2 : 17] : a.in[which == 0 ? 3 : 18];
            const float* nw = a.in[which == 0 ? 1 : 16] + (size_t)l * D;
            p0_item(src + (size_t)l * D * FF, FF, 64 * kb, 128 * pn + 32 * (j & 3), 32, nw, (bf16_t*)(wl + (which == 0 ? W_GU1 : W_GU2)), D, 32 * nb, scr, lane);
        } else if (which == 1 || which == 5) {
            const int nblk = D / 32, kb = r / nblk, nb = r % nblk;
            p0_item(a.in[which == 1 ? 4 : 19] + (size_t)l * FF * D, D, 64 * kb, 32 * nb, 32, nullptr, (bf16_t*)(wl + (which == 1 ? W_D1 : W_D2)), FF, 32 * nb, scr, lane);
        } else if (which == 2) {
            const int nblk = PL / 32, kb = r / nblk, nb = r % nblk;
            int sc, nv;
            if (nb < 40) { sc = 32 * nb; nv = 32; } else if (nb < 104) { sc = 32 * nb + 8; nv = 32; } else if (nb == 104) { sc = 1280; nv = 8; } else { sc = 0; nv = 0; }
            p0_item(a.in[6] + (size_t)l * D * DPROJ, DPROJ, 64 * kb, sc, nv, a.in[5] + (size_t)l * D, (bf16_t*)(wl + W_IN), D, 32 * nb, scr, lane);
        } else {
            const int nblk = D / 32, kb = r / nblk, nb = r % nblk;
            p0_item(a.in[15] + (size_t)l * D * D, D, 64 * kb, 32 * nb, 32, nullptr, (bf16_t*)(wl + W_OUT), D, 32 * nb, scr, lane);
        }
    }
}

DI void prologue(const Args& a, LAS unsigned char* lds, int gw, int NGW, int lane, int wave) {
    unsigned char* ws = a.ws;
    if (blockIdx.x == 0) { const int c = threadIdx.x; const float* lg = a.in[13];
        const float x0 = lg[c], x1 = lg[512 + c], x2 = lg[1024 + c], x3 = lg[1536 + c]; const float mx = fmaxf(fmaxf(x0, x1), fmaxf(x2, x3));
        const float e0 = __expf(x0 - mx), e1 = __expf(x1 - mx), e2 = __expf(x2 - mx), e3 = __expf(x3 - mx); const float inv = 1.0f / (e0 + e1 + e2 + e3);
        float* LB = (float*)(ws + WS_LB); LB[c] = 0.f; LB[512 + c] = e1 * inv; LB[1024 + c] = (e1 + e2) * inv; LB[1536 + c] = (e1 + e2 + e3) * inv; }
    { const float* x = a.in[0]; bf16_t* XB = (bf16_t*)(ws + WS_XB); float* ssq0 = (float*)(ws + WS_SSQ);
      for (int m0 = gw; m0 < M; m0 += 2 * NGW) { f32x4 v[2][4];
#pragma unroll
          for (int h = 0; h < 2; ++h) { const int m = m0 + h * NGW; const f32x4* xr = (const f32x4*)(x + (size_t)m * D) + lane;
#pragma unroll
              for (int j = 0; j < 4; ++j) v[h][j] = xr[64 * j]; }
#pragma unroll
          for (int h = 0; h < 2; ++h) { const int m = m0 + h * NGW; float s = 0.f;
#pragma unroll
              for (int j = 0; j < 4; ++j) s += (v[h][j].x * v[h][j].x + v[h][j].y * v[h][j].y) + (v[h][j].z * v[h][j].z + v[h][j].w * v[h][j].w);
              s = wave_sum(s);
              u32x2* o8 = (u32x2*)(XB + (size_t)m * D) + lane;
#pragma unroll
              for (int j = 0; j < 4; ++j) { u32x2 w; w.x = pk2(v[h][j].x, v[h][j].y); w.y = pk2(v[h][j].z, v[h][j].w); o8[64 * j] = w; }
              if (lane < 16) ssq0[(size_t)m * 16 + lane] = (lane == 0) ? s : 0.f; } } }
    convert_layer(a, 0, lds, gw, NGW, lane, wave);
}

struct MixL { bf16_t* proj; bf16_t* Y; bf16_t* XA; float* DTA; float* EBV; const float *conv_w, *conv_b, *dt_bias, *a_log, *dskip, *ssd_nw, *lb, *hg_nw; };


constexpr int SSD_STG = 73728, SSD_DT2 = 122880;
DI void ssd_dma(LAS unsigned char* lds, const MixL& P, size_t rowbase, int b, int g, int c, int tid, int wave) {
    const int t0 = c * 64;
    { const int cgi = tid & 31, run = tid >> 5;
      const int c0 = 256 * g + 8 * cgi;
#pragma unroll
      for (int j = 0; j < 4; ++j) __builtin_amdgcn_global_load_lds((const unsigned*)(P.XA + (rowbase + t0 + 4 * run + j) * 768 + c0), (LAS unsigned*)(lds + SSD_STG + j * 8192 + wave * 1024), 16, 0, 0); }
    if (wave < 4) { const int run = (tid & 127) >> 3;
      const int c0 = (wave < 2 ? 512 : 640) + 64 * g + 8 * (tid & 7);
#pragma unroll
      for (int j = 0; j < 4; ++j) __builtin_amdgcn_global_load_lds((const unsigned*)(P.XA + (rowbase + t0 + 4 * run + j) * 768 + c0), (LAS unsigned*)(lds + SSD_STG + 32768 + j * 4096 + wave * 1024), 16, 0, 0);
      __builtin_amdgcn_global_load_lds((const unsigned*)(P.DTA + (size_t)(b * 32 + c) * 2048 + wave * 512 + (4 * g + ((tid & 63) >> 4)) * 64 + 4 * (tid & 15)), (LAS unsigned*)(lds + SSD_DT2 + wave * 1024), 16, 0, 0); }
}
DI void ssd_unit(LAS unsigned char* lds, const MixL& P, int b, int g) {
    int tid_l = threadIdx.x; asm volatile("" : "+v"(tid_l));
    const int tid = tid_l, lane = tid & 63, wave = __builtin_amdgcn_readfirstlane(tid >> 6), l15 = lane & 15, q = lane >> 4;
    const int r = wave >> 1, hh = wave & 1;
    LAS unsigned char* XT = lds; LAS unsigned char* BMp = lds + 36864; LAS unsigned char* BTp = lds + 46080; LAS unsigned char* CMp = lds + 55296;
    LAS float* ACUM = (LAS float*)(lds + 64512); LAS float* DTV = ACUM + 256; LAS float* EA = ACUM + 512; LAS float* WV = ACUM + 768; LAS float* SSQP = ACUM + 1024;
    const float Dr = P.dskip[4 * g + r];
    const size_t rowbase = (size_t)b * SEQ;
    const int ycol = 256 * g + 64 * r + 32 * hh + 4 * q;
    const LAS unsigned char* XTr = XT + r * 64 * LS;
    const LAS float* ac = ACUM + r * 64; const LAS float* dtv = DTV + r * 64; const LAS float* ea = EA + r * 64; const LAS float* wv = WV + r * 64;
    f32x4 ST[4][2];
#pragma unroll
    for (int i = 0; i < 4; ++i)
#pragma unroll
        for (int j = 0; j < 2; ++j) ST[i][j] = (f32x4){0.f, 0.f, 0.f, 0.f};
    f32x4 nwv[2];
#pragma unroll
    for (int pt = 0; pt < 2; ++pt) nwv[pt] = *(const f32x4*)(P.ssd_nw + ycol + 16 * pt);
    ssd_dma(lds, P, rowbase, b, g, 0, tid, wave);
#pragma unroll 1
    for (int c = 0; c < SEQ / 64; ++c) {
        const int t0 = c * 64;
        asm volatile("s_waitcnt vmcnt(0)" ::: "memory");
#pragma unroll
        for (int pass = 0; pass < 2; ++pass) {
            if (pass == 0 || wave < 4) {
            const int cgi = pass ? (wave < 2 ? 32 : 40) + (tid & 7) : (tid & 31), run = pass ? ((tid & 127) >> 3) : (tid >> 5);
            u32x4 rv[4];
#pragma unroll
            for (int j = 0; j < 4; ++j) rv[j] = *(const LAS u32x4*)(lds + SSD_STG + (pass ? 32768 + j * 4096 : j * 8192) + tid * 16);
            u32x2 tv[8];
#pragma unroll
            for (int e = 0; e < 8; ++e) { const unsigned a0 = rv[0][e >> 1], a1 = rv[1][e >> 1], a2 = rv[2][e >> 1], a3 = rv[3][e >> 1];
                if (e & 1) { tv[e].x = (a0 >> 16) | (a1 & 0xffff0000u); tv[e].y = (a2 >> 16) | (a3 & 0xffff0000u); }
                else { tv[e].x = (a0 & 0xffffu) | (a1 << 16); tv[e].y = (a2 & 0xffffu) | (a3 << 16); } }
            if (cgi < 32) { const int rr = cgi >> 3, p0 = 8 * (cgi & 7);
#pragma unroll
                for (int e = 0; e < 8; ++e) *(LAS u32x2*)(XT + (rr * 64 + p0 + e) * LS + ((run ^ ((cgi & 1) | (((cgi >> 2) & 7) << 1))) << 3)) = tv[e];
            } else if (cgi < 40) { const int n0 = 8 * (cgi - 32);
#pragma unroll
                for (int j = 0; j < 4; ++j) *(LAS u32x4*)(BMp + (4 * run + j) * LS + n0 * 2) = rv[j];
#pragma unroll
                for (int e = 0; e < 8; ++e) *(LAS u32x2*)(BTp + (n0 + e) * LS + ((run ^ (cgi & 1)) << 3)) = tv[e];
            } else { const int n0 = 8 * (cgi - 40);
#pragma unroll
                for (int j = 0; j < 4; ++j) *(LAS u32x4*)(CMp + (4 * run + j) * LS + n0 * 2) = rv[j];
            }
            }
        }
        if (wave < 4) *(LAS u32x4*)(ACUM + 4 * tid) = *(const LAS u32x4*)(lds + SSD_DT2 + tid * 16);
        __syncthreads();
        u32x2 zr[2][4];
#pragma unroll
        for (int pt = 0; pt < 2; ++pt)
#pragma unroll
            for (int ti = 0; ti < 4; ++ti) zr[pt][ti] = *(const u32x2*)(P.proj + (rowbase + t0 + 16 * ti + l15) * PL + ycol + 16 * pt);
        if (c + 1 < SEQ / 64) ssd_dma(lds, P, rowbase, b, g, c + 1, tid, wave);
        bf16x8 bmp[4][2], cmp[4][2], xtp[2][2];
#pragma unroll
        for (int i = 0; i < 4; ++i)
#pragma unroll
            for (int kk = 0; kk < 2; ++kk) { bmp[i][kk] = ld_perm(BMp, 16 * i + l15, kk, q); cmp[i][kk] = ld_perm(CMp, 16 * i + l15, kk, q); }
#pragma unroll
        for (int pt = 0; pt < 2; ++pt)
#pragma unroll
            for (int kk = 0; kk < 2; ++kk) { const int gsw = (l15 >> 3) | (hh << 1) | (r << 2);
                const LAS unsigned char* pr_ = XTr + (32 * hh + 16 * pt + l15) * LS;
                const s16x4 lo_ = *(const LAS s16x4*)(pr_ + (((kk * 8 + q) ^ gsw) << 3)), hi_ = *(const LAS s16x4*)(pr_ + (((kk * 8 + q + 4) ^ gsw) << 3));
                xtp[pt][kk] = __builtin_shufflevector(lo_, hi_, 0, 1, 2, 3, 4, 5, 6, 7); }
        float at[4], eat[4]; f32x4 as4[4], ds4[4];
#pragma unroll
        for (int i = 0; i < 4; ++i) { at[i] = ac[16 * i + l15]; eat[i] = ea[16 * i + l15]; as4[i] = *(const LAS f32x4*)(ac + 16 * i + 4 * q); ds4[i] = *(const LAS f32x4*)(dtv + 16 * i + 4 * q); }
        const float eaend = ea[63];
        f32x4 y[2][4];
#pragma unroll
        for (int ti = 0; ti < 4; ++ti) {
            f32x4 lt[4];
#pragma unroll
            for (int sj = 0; sj < 4; ++sj) {
                if (sj <= ti) {
                    f32x4 ga = (f32x4){0.f, 0.f, 0.f, 0.f};
                    ga = mma(bmp[sj][0], cmp[ti][0], ga); ga = mma(bmp[sj][1], cmp[ti][1], ga);
#pragma unroll
                    for (int rr = 0; rr < 4; ++rr) { float v = ga[rr] * __expf(at[ti] - as4[sj][rr]) * ds4[sj][rr];
                        if (sj == ti) { const int sl = 4 * q + rr; v = (sl <= l15) ? v : 0.f; v = (sl == l15) ? v + Dr : v; }
                        lt[sj][rr] = v; }
                } else lt[sj] = (f32x4){0.f, 0.f, 0.f, 0.f};
            }
            const bf16x8 lf0 = pack8(lt[0], lt[1]), lf1 = pack8(lt[2], lt[3]);
#pragma unroll
            for (int pt = 0; pt < 2; ++pt) { f32x4 a = (f32x4){0.f, 0.f, 0.f, 0.f}; a = mma(xtp[pt][0], lf0, a); if (ti >= 2) a = mma(xtp[pt][1], lf1, a); y[pt][ti] = a; }
        }
#pragma unroll
        for (int pt = 0; pt < 2; ++pt) { const bf16x8 sf0 = pack8(ST[0][pt], ST[1][pt]), sf1 = pack8(ST[2][pt], ST[3][pt]);
#pragma unroll
            for (int ti = 0; ti < 4; ++ti) { f32x4 a = (f32x4){0.f, 0.f, 0.f, 0.f}; a = mma(sf0, cmp[ti][0], a); a = mma(sf1, cmp[ti][1], a); y[pt][ti] += a * eat[ti]; } }
        { bf16x8 xw[2][2];
#pragma unroll
          for (int kk = 0; kk < 2; ++kk) { const f32x4 wlo = *(const LAS f32x4*)(wv + 32 * kk + 4 * q), whi = *(const LAS f32x4*)(wv + 32 * kk + 16 + 4 * q);
#pragma unroll
              for (int pt = 0; pt < 2; ++pt) xw[pt][kk] = scale8(xtp[pt][kk], wlo, whi); }
#pragma unroll
          for (int nj = 0; nj < 4; ++nj) { const bf16x8 b0 = ld_perm(BTp, 16 * nj + l15, 0, q ^ (l15 >> 3)), b1 = ld_perm(BTp, 16 * nj + l15, 1, q ^ (l15 >> 3));
#pragma unroll
              for (int pt = 0; pt < 2; ++pt) { f32x4 a = ST[nj][pt] * eaend; a = mma(b0, xw[pt][0], a); a = mma(b1, xw[pt][1], a); ST[nj][pt] = a; } } }
        float sq[4] = {0.f, 0.f, 0.f, 0.f};
#pragma unroll
        for (int pt = 0; pt < 2; ++pt)
#pragma unroll
            for (int ti = 0; ti < 4; ++ti) { const u32x2 zz = zr[pt][ti];
                const float z0 = __uint_as_float(zz.x << 16), z1 = __uint_as_float(zz.x & 0xffff0000u), z2 = __uint_as_float(zz.y << 16), z3 = __uint_as_float(zz.y & 0xffff0000u);
                f32x4 v = y[pt][ti]; v[0] *= z0; v[1] *= z1; v[2] *= z2; v[3] *= z3; y[pt][ti] = v;
                sq[ti] += (v[0] * v[0] + v[1] * v[1]) + (v[2] * v[2] + v[3] * v[3]); }
#pragma unroll
        for (int ti = 0; ti < 4; ++ti) { float s = sq[ti]; s += __shfl_xor(s, 16); s += __shfl_xor(s, 32); if (q == 0) SSQP[wave * 64 + 16 * ti + l15] = s; }
        asm volatile("s_waitcnt lgkmcnt(0)" ::: "memory"); __builtin_amdgcn_s_barrier(); asm volatile("" ::: "memory");
#pragma unroll
        for (int ti = 0; ti < 4; ++ti) { float tot = 0.f;
#pragma unroll
            for (int w8 = 0; w8 < 8; ++w8) tot += SSQP[w8 * 64 + 16 * ti + l15];
            const float rs = __builtin_amdgcn_rsqf(tot * (1.0f / 256.0f) + pg8::RMS_EPS);
#pragma unroll
            for (int pt = 0; pt < 2; ++pt) { const f32x4 o = y[pt][ti] * rs * nwv[pt];
                u32x2 w2; w2.x = pk2(o[0], o[1]); w2.y = pk2(o[2], o[3]);
                *(u32x2*)(P.Y + (rowbase + t0 + 16 * ti + l15) * D + ycol + 16 * pt) = w2; } }
    }
}


constexpr int HG_STG = 81920;
DI void hg_dma(LAS unsigned char* lds, const MixL& P, size_t rowbase, int h, int c, int tid, int wave) {
    const int tc = tid & 255, cg = tc & 7, tp = tc >> 3;
    const bf16_t* pr = P.proj + (rowbase + c * 64 + 2 * tp) * PL + 64 * h + 8 * cg;
    __builtin_amdgcn_global_load_lds((const unsigned*)(pr + 1280), (LAS unsigned*)(lds + HG_STG + 0 * 8192 + wave * 1024), 16, 0, 0);
    __builtin_amdgcn_global_load_lds((const unsigned*)(pr + PL + 1280), (LAS unsigned*)(lds + HG_STG + 1 * 8192 + wave * 1024), 16, 0, 0);
    __builtin_amdgcn_global_load_lds((const unsigned*)(pr + 1792), (LAS unsigned*)(lds + HG_STG + 2 * 8192 + wave * 1024), 16, 0, 0);
    __builtin_amdgcn_global_load_lds((const unsigned*)(pr + PL + 1792), (LAS unsigned*)(lds + HG_STG + 3 * 8192 + wave * 1024), 16, 0, 0);
    __builtin_amdgcn_global_load_lds((const unsigned*)(pr + 2304), (LAS unsigned*)(lds + HG_STG + 4 * 8192 + wave * 1024), 16, 0, 0);
    __builtin_amdgcn_global_load_lds((const unsigned*)(pr + PL + 2304), (LAS unsigned*)(lds + HG_STG + 5 * 8192 + wave * 1024), 16, 0, 0);
}
DI void hg_unit(LAS unsigned char* lds, const MixL& P, int pi) {
    int tid_l = threadIdx.x; asm volatile("" : "+v"(tid_l));
    const int tid = tid_l, lane = tid & 63, wave = __builtin_amdgcn_readfirstlane(tid >> 6), l15 = lane & 15, q = lane >> 4;
    const int chain = wave >> 2, wv = wave & 3, ci = 2 * pi + chain, b = ci >> 3, h = ci & 7;
    LAS unsigned char* base = lds + chain * 40960;
    LAS unsigned char* QE = base; LAS unsigned char* KE = base + 9216; LAS unsigned char* KET = base + 18432; LAS unsigned char* VT = base + 27648;
    LAS float* EBREF = (LAS float*)(base + 36864); LAS float* EBLR = EBREF + 64; LAS float* EBLAST = EBREF + 128; LAS float* CUMQ = EBREF + 192; LAS float* SSQP = EBREF + 448;
    const int d = lane, tq = wv;
    const size_t rowbase = (size_t)b * SEQ;
    const int ycol = 64 * h + 16 * wv + 4 * q;
    f32x4 SD[4];
#pragma unroll
    for (int i = 0; i < 4; ++i) SD[i] = (f32x4){0.f, 0.f, 0.f, 0.f};
    const f32x4 nw = *(const f32x4*)(P.hg_nw + 16 * wv + 4 * q);
    hg_dma(lds, P, rowbase, h, 0, tid, wave);
#pragma unroll 1
    for (int c = 0; c < SEQ / 64; ++c) {
        const int t0 = c * 64;
        asm volatile("s_waitcnt vmcnt(0)" ::: "memory"); __syncthreads();
        float qv[16], kv[16], cs[16]; unsigned vv[8]; float runs = 0.f;
#pragma unroll
        for (int i = 0; i < 16; ++i) { const LAS unsigned char* sp = lds + HG_STG + (i & 1) * 8192 + (chain * 256 + (8 * tq + (i >> 1)) * 8 + (d >> 3)) * 16 + (d & 7) * 2;
            const float a = bf2f(*(const LAS unsigned short*)(sp + 2 * 8192)), qr = bf2f(*(const LAS unsigned short*)sp); const unsigned vb = *(const LAS unsigned short*)(sp + 4 * 8192);
            if (i & 1) vv[i >> 1] |= vb << 16; else vv[i >> 1] = vb;
            runs += a; cs[i] = runs; qv[i] = qr; kv[i] = 1.0f - __expf(a); }
        CUMQ[tq * 64 + d] = runs;
        __syncthreads();
        { const float c0 = CUMQ[d], c1 = CUMQ[64 + d], c2 = CUMQ[128 + d], c3 = CUMQ[192 + d];
          const float bref = c0 + c1, blast = bref + (c2 + c3);
          const float pre = (tq == 0) ? 0.f : (tq == 1 ? c0 : (tq == 2 ? bref : bref + c2));
          unsigned kt[8];
#pragma unroll
          for (int i = 0; i < 16; i += 2) { const float b0 = pre + cs[i], b1 = pre + cs[i + 1];
              const unsigned qp = pk2(qv[i] * __expf(b0 - bref), qv[i + 1] * __expf(b1 - bref)), kp = pk2(kv[i] * __expf(bref - b0), kv[i + 1] * __expf(bref - b1));
              *(LAS unsigned short*)(QE + (16 * tq + i) * LS + d * 2) = (unsigned short)(qp & 0xffffu); *(LAS unsigned short*)(QE + (16 * tq + i + 1) * LS + d * 2) = (unsigned short)(qp >> 16);
              *(LAS unsigned short*)(KE + (16 * tq + i) * LS + d * 2) = (unsigned short)(kp & 0xffffu); *(LAS unsigned short*)(KE + (16 * tq + i + 1) * LS + d * 2) = (unsigned short)(kp >> 16);
              kt[i >> 1] = kp; }
          *(LAS u32x4*)(KET + d * LS + tq * 32) = (u32x4){kt[0], kt[1], kt[2], kt[3]}; *(LAS u32x4*)(KET + d * LS + tq * 32 + 16) = (u32x4){kt[4], kt[5], kt[6], kt[7]};
          *(LAS u32x4*)(VT + d * LS + tq * 32) = (u32x4){vv[0], vv[1], vv[2], vv[3]}; *(LAS u32x4*)(VT + d * LS + tq * 32 + 16) = (u32x4){vv[4], vv[5], vv[6], vv[7]};
          if (tq == 0) { EBREF[d] = __expf(bref); EBLR[d] = __expf(blast - bref); EBLAST[d] = __expf(blast); } }
        __syncthreads();
        u32x2 gr[4];
#pragma unroll
        for (int ti = 0; ti < 4; ++ti) gr[ti] = *(const u32x2*)(P.proj + (rowbase + t0 + 16 * ti + l15) * PL + 2816 + ycol);
        if (c + 1 < SEQ / 64) hg_dma(lds, P, rowbase, h, c + 1, tid, wave);
        bf16x8 kep[4][2], qep[4][2], vtp[2];
#pragma unroll
        for (int i = 0; i < 4; ++i)
#pragma unroll
            for (int kk = 0; kk < 2; ++kk) { kep[i][kk] = ld_perm(KE, 16 * i + l15, kk, q); qep[i][kk] = ld_perm(QE, 16 * i + l15, kk, q); }
#pragma unroll
        for (int kk = 0; kk < 2; ++kk) vtp[kk] = ld_perm(VT, 16 * wv + l15, kk, q);
        f32x4 o[4];
#pragma unroll
        for (int ti = 0; ti < 4; ++ti) {
            f32x4 pt_[4];
#pragma unroll
            for (int sj = 0; sj < 4; ++sj) {
                if (sj <= ti) { f32x4 a = (f32x4){0.f, 0.f, 0.f, 0.f}; a = mma(kep[sj][0], qep[ti][0], a); a = mma(kep[sj][1], qep[ti][1], a);
                    if (sj == ti) {
#pragma unroll
                        for (int rr = 0; rr < 4; ++rr) a[rr] = (4 * q + rr <= l15) ? a[rr] : 0.f; }
                    pt_[sj] = a;
                } else pt_[sj] = (f32x4){0.f, 0.f, 0.f, 0.f};
            }
            const bf16x8 pf0 = pack8(pt_[0], pt_[1]), pf1 = pack8(pt_[2], pt_[3]);
            f32x4 a = (f32x4){0.f, 0.f, 0.f, 0.f}; a = mma(vtp[0], pf0, a); if (ti >= 2) a = mma(vtp[1], pf1, a); o[ti] = a;
        }
        { f32x4 er[4];
#pragma unroll
          for (int dj = 0; dj < 4; ++dj) er[dj] = *(const LAS f32x4*)(EBREF + 16 * dj + 4 * q);
          const bf16x8 sf0 = pack8(SD[0] * er[0], SD[1] * er[1]), sf1 = pack8(SD[2] * er[2], SD[3] * er[3]);
#pragma unroll
          for (int ti = 0; ti < 4; ++ti) { o[ti] = mma(sf0, qep[ti][0], o[ti]); o[ti] = mma(sf1, qep[ti][1], o[ti]); } }
#pragma unroll
        for (int dj = 0; dj < 4; ++dj) { f32x4 a = (f32x4){0.f, 0.f, 0.f, 0.f};
            a = mma(ld_perm(KET, 16 * dj + l15, 0, q), vtp[0], a); a = mma(ld_perm(KET, 16 * dj + l15, 1, q), vtp[1], a);
            const f32x4 el = *(const LAS f32x4*)(EBLAST + 16 * dj + 4 * q), elr = *(const LAS f32x4*)(EBLR + 16 * dj + 4 * q);
            SD[dj] = SD[dj] * el + a * elr; }
#pragma unroll
        for (int ti = 0; ti < 4; ++ti) { const f32x4 v = o[ti]; float s = (v[0] * v[0] + v[1] * v[1]) + (v[2] * v[2] + v[3] * v[3]); s += __shfl_xor(s, 16); s += __shfl_xor(s, 32);
            if (q == 0) SSQP[wv * 64 + 16 * ti + l15] = s; }
        asm volatile("s_waitcnt lgkmcnt(0)" ::: "memory"); __builtin_amdgcn_s_barrier(); asm volatile("" ::: "memory");
#pragma unroll
        for (int ti = 0; ti < 4; ++ti) { const float tot = (SSQP[16 * ti + l15] + SSQP[64 + 16 * ti + l15]) + (SSQP[128 + 16 * ti + l15] + SSQP[192 + 16 * ti + l15]);
            const float rs = __builtin_amdgcn_rsqf(tot * (1.0f / 64.0f) + pg8::RMS_EPS); const u32x2 gg = gr[ti];
            const float g0 = __uint_as_float(gg.x << 16), g1 = __uint_as_float(gg.x & 0xffff0000u), g2 = __uint_as_float(gg.y << 16), g3 = __uint_as_float(gg.y & 0xffff0000u);
            f32x4 ov = o[ti] * rs * nw; ov[0] *= g0; ov[1] *= g1; ov[2] *= g2; ov[3] *= g3;
            u32x2 w2; w2.x = pk2(ov[0], ov[1]); w2.y = pk2(ov[2], ov[3]);
            *(u32x2*)(P.Y + (rowbase + t0 + 16 * ti + l15) * D + 512 + ycol) = w2; }
    }
}


DI void prep_ssd(const MixL& P, int b, int c) {
    int tid_l = threadIdx.x; asm volatile("" : "+v"(tid_l));
    const int tid = tid_l, lane = tid & 63, wave = __builtin_amdgcn_readfirstlane(tid >> 6);
    const size_t rowbase = (size_t)b * SEQ; const int t0 = c * 64;
    if (tid < 480) {
        const int cgi = tid % 96, r5 = tid / 96, c0 = 8 * cgi;
        float w[4][8], bias[8];
#pragma unroll
        for (int k = 0; k < 4; ++k) { const f32x4 w0 = *(const f32x4*)(P.conv_w + k * 768 + c0), w1 = *(const f32x4*)(P.conv_w + k * 768 + c0 + 4);
            w[k][0] = w0[0]; w[k][1] = w0[1]; w[k][2] = w0[2]; w[k][3] = w0[3]; w[k][4] = w1[0]; w[k][5] = w1[1]; w[k][6] = w1[2]; w[k][7] = w1[3]; }
        { const f32x4 b0 = *(const f32x4*)(P.conv_b + c0), b1 = *(const f32x4*)(P.conv_b + c0 + 4);
          bias[0] = b0[0]; bias[1] = b0[1]; bias[2] = b0[2]; bias[3] = b0[3]; bias[4] = b1[0]; bias[5] = b1[1]; bias[6] = b1[2]; bias[7] = b1[3]; }
        const bf16_t* src = P.proj + rowbase * PL + 512 + c0;
        u32x4 nxt[7];
#pragma unroll
        for (int i = 0; i < 7; ++i) { const int tok = t0 + 4 * r5 - 3 + i; nxt[i] = (tok >= 0) ? *(const u32x4*)(src + (size_t)tok * PL) : (u32x4){0u, 0u, 0u, 0u}; }
#pragma unroll 1
        for (int run = r5; run < 16; run += 5) {
            u32x4 raw[7];
#pragma unroll
            for (int i = 0; i < 7; ++i) raw[i] = nxt[i];
            if (run + 5 < 16) {
#pragma unroll
                for (int i = 0; i < 7; ++i) nxt[i] = *(const u32x4*)(src + (size_t)(t0 + 4 * (run + 5) - 3 + i) * PL); }
            u32x4 rv[4];
#pragma unroll
            for (int jp = 0; jp < 2; ++jp) {
                float v0[8], v1[8];
#pragma unroll
                for (int e = 0; e < 8; ++e) { float a0 = bias[e], a1 = bias[e];
#pragma unroll
                    for (int k = 0; k < 4; ++k) {
                        const unsigned d0 = raw[2 * jp + k][e >> 1], d1 = raw[2 * jp + 1 + k][e >> 1];
                        const float f0 = (e & 1) ? __uint_as_float(d0 & 0xffff0000u) : __uint_as_float(d0 << 16);
                        const float f1 = (e & 1) ? __uint_as_float(d1 & 0xffff0000u) : __uint_as_float(d1 << 16);
                        a0 += w[k][e] * f0; a1 += w[k][e] * f1; }
                    v0[e] = silu_f(a0); v1[e] = silu_f(a1); }
#pragma unroll
                for (int e2 = 0; e2 < 4; ++e2) { rv[2 * jp][e2] = pk2(v0[2 * e2], v0[2 * e2 + 1]); rv[2 * jp + 1][e2] = pk2(v1[2 * e2], v1[2 * e2 + 1]); }
            }
#pragma unroll
            for (int j = 0; j < 4; ++j) *(u32x4*)(P.XA + (rowbase + t0 + 4 * run + j) * 768 + c0) = rv[j];
        }
    }
    {
        float* dta = P.DTA + (size_t)(b * 32 + c) * 2048; const int hd = wave;
        const float x = bf2f(P.proj[(rowbase + t0 + lane) * PL + 3328 + hd]) + P.dt_bias[hd];
        const float dt = (x > 20.f) ? x : log1pf(__expf(x));
        float a = dt * (-__expf(P.a_log[hd]));
#pragma unroll
        for (int o = 1; o < 64; o <<= 1) { const float v = __shfl_up(a, o); if (lane >= o) a += v; }
        const float aend = __shfl(a, 63);
        dta[hd * 64 + lane] = a; dta[512 + hd * 64 + lane] = dt; dta[1024 + hd * 64 + lane] = __expf(a); dta[1536 + hd * 64 + lane] = dt * __expf(aend - a);
    }
}

__global__ void __launch_bounds__(NTHR, 2) hymba_fwd(Args a) {
    extern __shared__ __attribute__((aligned(16))) unsigned char lds_raw[];
    LAS unsigned char* lds = (LAS unsigned char*)lds_raw;
    cg::grid_group grid = cg::this_grid();
#define GSYNC0() do { asm volatile("s_waitcnt vmcnt(0) lgkmcnt(0)" ::: "memory"); grid.sync(); __builtin_amdgcn_fence(__ATOMIC_ACQUIRE, "agent"); asm volatile("s_waitcnt vmcnt(0)" ::: "memory"); } while (0)
#define GSYNC() do { XcdBarrier b_; b_.bar = (unsigned*)a.ws; b_.x = xb_xcc_id(); b_.st = (volatile LAS unsigned*)(lds + MISC_OFF) + 8; xcd_barrier(b_); } while (0)
    const int tid = threadIdx.x, lane = tid & 63, wave = __builtin_amdgcn_readfirstlane(tid >> 6);
    const int G = gridDim.x, gw = blockIdx.x * NWAVES + wave, NGW = G * NWAVES;
    unsigned char* ws = a.ws;
    float* ssq = (float*)(ws + WS_SSQ);
    bf16_t* XB = (bf16_t*)(ws + WS_XB); bf16_t* YB = (bf16_t*)(ws + WS_Y); bf16_t* RB = (bf16_t*)(ws + WS_R);
    float* out = a.out;

    { volatile LAS unsigned* MISC = (volatile LAS unsigned*)(lds + MISC_OFF); if (tid < 64) MISC[tid] = 0u; }
    __syncthreads();
    (void)xcd_barrier_post((unsigned*)ws, (volatile LAS unsigned*)(lds + MISC_OFF) + 8);
    prologue(a, lds, gw, NGW, lane, wave);
    GSYNC0();

#pragma unroll 1
    for (int ph = 0; ph < DEPTH * 8; ++ph) {
        const int l = ph >> 3, k = ph & 7;
        unsigned char* wl = ws + WS_W + (size_t)l * W_LAYER;
        if (k == 0 || k == 6) {
#ifndef NO_GU
            pg8::Gemm g{XB, (const bf16_t*)(wl + (k == 0 ? W_GU1 : W_GU2)), M, NGU, D}; pg8::StaticOrder S; S.init(M, NGU, G, (int)blockIdx.x);
            pg8::EpiGU E{RB, ssq + (size_t)(3 * l + (k == 0 ? 0 : 2)) * M * 16, FF, lds + RSC_OFF + tid * 32, -1};
            pg8::gemm_phase<pg8::EpiGU, pg8::StaticOrder, true, true>(lds, g, S, E);
#endif
        } else if (k == 1 || k == 5 || k == 7) {
#ifndef NO_RES
            const int KK = (k == 5) ? D : FF;
            pg8::Gemm g{k == 5 ? YB : RB, (const bf16_t*)(wl + (k == 1 ? W_D1 : (k == 5 ? W_OUT : W_D2))), M, D, KK}; pg8::RevOrder S; S.init(M, D, G, (int)blockIdx.x);
            pg8::EpiRes E{XB, ssq + (size_t)(3 * l + (k == 1 ? 1 : (k == 5 ? 2 : 3))) * M * 16, k == 5 ? 1.0f : 0.5f};
            pg8::gemm_phase<pg8::EpiRes, pg8::RevOrder, true, true>(lds, g, S, E);
#endif
        } else if (k == 2) {
#ifndef NO_PROJ
            pg8::Gemm g{XB, (const bf16_t*)(wl + W_IN), M, PL, D}; pg8::StaticOrder S; S.init(M, PL, G, (int)blockIdx.x);
            pg8::EpiProj E{RB, ssq + (size_t)(3 * l + 1) * M * 16, PL, lds + RSC_OFF + tid * 32, (const float*)(ws + WS_LB) + l * 512, -1};
            pg8::gemm_phase<pg8::EpiProj, pg8::StaticOrder, true, true>(lds, g, S, E);
#endif
        } else {
            MixL P{RB, YB, (bf16_t*)out  , (float*)(ws + WS_DTA), (float*)(ws + WS_EBV), a.in[7] + (size_t)l * 4 * 768, a.in[8] + (size_t)l * 768, a.in[9] + l * 8, a.in[10] + l * 8, a.in[11] + l * 8, a.in[12] + l * 512,
                   (const float*)(ws + WS_LB) + l * 512, a.in[14] + l * 64};
            if (k == 3) {
                for (int u = blockIdx.x; u < 1024; u += G) prep_ssd(P, u >> 5, u & 31);
            } else {
                if (l + 1 < DEPTH && (G <= 192 || (int)blockIdx.x >= 192)) {
                    const int cb = G > 192 ? (int)blockIdx.x - 192 : (int)blockIdx.x, cn = G > 192 ? G - 192 : G;
                    convert_layer(a, l + 1, lds, cb * NWAVES + wave, cn * NWAVES, lane, wave); __syncthreads(); }
                for (int u = blockIdx.x; u < 192; u += G) {
#ifndef NO_SSD
                    if (u < 64) ssd_unit(lds, P, u >> 1, u & 1);
#endif
#ifndef NO_HG
                    if (u >= 64) hg_unit(lds, P, u - 64);
#endif
                    __syncthreads(); }
            }
        }
        GSYNC();
    }
    { const float* fn = a.in[20]; const float* sq = ssq + (size_t)12 * M * 16;
      for (int m = gw; m < M; m += NGW) { const float rs = pg8::row_rs(sq, (unsigned)m);
          const u32x4* xr = (const u32x4*)(XB + (size_t)m * D); f32x4* orow = (f32x4*)(out + (size_t)m * D);
#pragma unroll
          for (int hlf = 0; hlf < 2; ++hlf) { const u32x4 bv = xr[64 * hlf + lane]; const f32x4 w0 = ((const f32x4*)fn)[2 * (64 * hlf + lane)], w1 = ((const f32x4*)fn)[2 * (64 * hlf + lane) + 1];
              const f32x4 b0 = {__uint_as_float(bv.x << 16), __uint_as_float(bv.x & 0xffff0000u), __uint_as_float(bv.y << 16), __uint_as_float(bv.y & 0xffff0000u)};
              const f32x4 b1 = {__uint_as_float(bv.z << 16), __uint_as_float(bv.z & 0xffff0000u), __uint_as_float(bv.w << 16), __uint_as_float(bv.w & 0xffff0000u)};
              orow[2 * (64 * hlf + lane)] = b0 * rs * w0; orow[2 * (64 * hlf + lane) + 1] = b1 * rs * w1; } } }
}

extern "C" void kernel_launch(void* const* d_in, const int* in_sizes, int n_in, void* d_out, int out_size, void* d_ws, size_t ws_size, hipStream_t stream) {
    static int grid = 0;
    if (grid == 0) {
        if (n_in != 21 || in_sizes[0] != M * D || out_size != M * D || ws_size < WS_END) { fprintf(stderr, "kernel_launch: unexpected shapes (n_in %d, in0 %d, out %d, ws %zu); nothing launched\n", n_in, n_in > 0 ? in_sizes[0] : -1, out_size, ws_size); grid = -1; return; }
        int dev = 0, cus = 0, per_cu = 0;
        if (hipGetDevice(&dev) != hipSuccess || hipDeviceGetAttribute(&cus, hipDeviceAttributeMultiprocessorCount, dev) != hipSuccess) { fprintf(stderr, "kernel_launch: device query failed\n"); grid = -1; return; }
        if (hipFuncSetAttribute((const void*)hymba_fwd, hipFuncAttributeMaxDynamicSharedMemorySize, LDS_BYTES) != hipSuccess) { fprintf(stderr, "kernel_launch: hipFuncSetAttribute failed\n"); grid = -1; return; }
        if (hipOccupancyMaxActiveBlocksPerMultiprocessor(&per_cu, (const void*)hymba_fwd, NTHR, LDS_BYTES) != hipSuccess || per_cu < 1) { fprintf(stderr, "kernel_launch: occupancy query gave %d\n", per_cu); per_cu = 1; }
        (void)hipGetLastError();
        grid = cus;
    }
    if (grid < 0) return;
    if (hipMemsetAsync(d_ws, 0, 16384, stream) != hipSuccess) { fprintf(stderr, "kernel_launch: hipMemsetAsync failed\n"); return; }
    Args a{};
    for (int i = 0; i < 21; ++i) a.in[i] = (const float*)d_in[i];
    a.out = (float*)d_out; a.ws = (unsigned char*)d_ws;
    void* args[] = {&a};
    const hipError_t e = hipLaunchCooperativeKernel((const void*)hymba_fwd, dim3(grid), dim3(NTHR), args, LDS_BYTES, stream);
    if (e != hipSuccess) fprintf(stderr, "kernel_launch: cooperative launch failed: %s (grid %d)\n", hipGetErrorString(e), grid);
}
```

```cpp
#include <hip/hip_runtime.h>
#include <hip/hip_cooperative_groups.h>
#include <cstdio>
#include <cstdint>
namespace cg = cooperative_groups;

namespace pg8 {
#define PG8_LAS __attribute__((address_space(3)))
typedef unsigned short bf16_t;
typedef short bf16x8 __attribute__((ext_vector_type(8)));
typedef float f32x4 __attribute__((ext_vector_type(4)));
typedef unsigned u32x4 __attribute__((ext_vector_type(4)));
constexpr int BM = 256, BK = 64, HALF = 128, HTB = HALF * BK * 2  , STAGE_BYTES = 8 * HTB, NXCD = 8, WGM = 8;

__host__ __device__ __forceinline__ int lds_byte(int r, int c) { const int st = (r >> 4) * 2 + (c >> 5), rr = r & 15, cc = c & 31, ob = rr * 64 + cc * 2; return st * 1024 + (ob ^ (((ob >> 9) & 1) << 5)); }
__host__ __device__ __forceinline__ void stage_rc(int b, int& R, int& C) { const int st = b / 1024, sb = b % 1024, swz = sb ^ (((sb >> 9) & 1) << 5); R = (st >> 1) * 16 + swz / 64; C = (st & 1) * 32 + (swz % 64) / 2; }
__host__ __device__ __forceinline__ int perm32(int rho) { const int n = rho >> 4, i = rho & 15; return 8 * (i >> 2) + 4 * n + (i & 3); }

struct Unit { int pm, pn; };
struct Gemm { const bf16_t* A; const bf16_t* Bt; int M, N, K; };

struct StaticOrder {
    int nM, nN, nwg, G, c;
    __host__ __device__ void init(int M, int N, int G_, int c_) { nM = M / BM; nN = N / BM; nwg = nM * nN; G = G_; c = c_; }
    __host__ __device__ bool next(int i, Unit& u) const {
        const long L = (long)i * G + c; if (L >= nwg) return false;
        int wgid = (int)L; const int xcd_ = wgid % NXCD; { const int q = nwg / NXCD, r = nwg % NXCD, xcd = wgid % NXCD, off = wgid / NXCD; wgid = (xcd < r ? xcd * (q + 1) : r * (q + 1) + (xcd - r) * q) + off; }
        const int nig = WGM * nN, gid = wgid / nig, fm = gid * WGM, gsz = (nM - fm) < WGM ? (nM - fm) : WGM;
        u.pm = fm + ((wgid % nig) % gsz); u.pn = ((wgid % nig) / gsz + (xcd_ * nN) / NXCD) % nN;
        return true;
    }
    __device__ __forceinline__ void a_ready(const Unit&) const {}
    __device__ __forceinline__ void done(const Unit&) const {}
};


typedef __bf16 bf16x2n __attribute__((ext_vector_type(2)));
typedef float f32x2n __attribute__((ext_vector_type(2)));
__device__ __forceinline__ unsigned pk2(float lo, float hi) { f32x2n v = {lo, hi}; bf16x2n b = __builtin_convertvector(v, bf16x2n); return __builtin_bit_cast(unsigned, b); }
__device__ __forceinline__ float silu_f(float x) { return x * __builtin_amdgcn_rcpf(1.0f + __expf(-x)); }

struct RevOrder : StaticOrder {
    __host__ __device__ bool next(int i, Unit& u) const { if (nwg % G != 0) return StaticOrder::next(i, u);
        const int nr = nwg / G; if (i >= nr) return false; return StaticOrder::next(nr - 1 - i, u); }
};
constexpr float RMS_EPS = 1e-6f;
__device__ __forceinline__ float row_rs(const float* ssq, unsigned row) {
    const f32x4* sp = (const f32x4*)(ssq + (size_t)row * 16); const f32x4 a = (sp[0] + sp[1]) + (sp[2] + sp[3]);
    return __builtin_amdgcn_rsqf(((a[0] + a[1]) + (a[2] + a[3])) * (1.0f / 1024.0f) + RMS_EPS);
}
#define PG8_RS8(ssq_, u_, row0_, rsv_, slot_, last_pm_) do { \
    if ((u_).pm != (last_pm_)) { _Pragma("unroll") for (int i_ = 0; i_ < 8; ++i_) (rsv_)[i_] = row_rs((ssq_), (row0_) + (i_ >> 2) * HALF + (i_ & 3) * 16); \
        *(PG8_LAS f32x4*)(slot_) = (f32x4){(rsv_)[0], (rsv_)[1], (rsv_)[2], (rsv_)[3]}; *(PG8_LAS f32x4*)((slot_) + 16) = (f32x4){(rsv_)[4], (rsv_)[5], (rsv_)[6], (rsv_)[7]}; (last_pm_) = (u_).pm; } \
    else { const f32x4 a_ = *(const PG8_LAS f32x4*)(slot_), b_ = *(const PG8_LAS f32x4*)((slot_) + 16); \
        (rsv_)[0] = a_[0]; (rsv_)[1] = a_[1]; (rsv_)[2] = a_[2]; (rsv_)[3] = a_[3]; (rsv_)[4] = b_[0]; (rsv_)[5] = b_[1]; (rsv_)[6] = b_[2]; (rsv_)[7] = b_[3]; } } while (0)
struct EpiGU {
    static constexpr bool PERM = true, AFTER_DRAIN = false;
    bf16_t* H; const float* ssq; int ldh; PG8_LAS unsigned char* slot; mutable int last_pm;
    __device__ __forceinline__ void operator()(const f32x4 (&acc)[2][2][4][2], const Unit& u, int wr, int wc, int fr, int fq) const {
        const int row0 = u.pm * BM + wr * 64 + fr, col0 = u.pn * HALF + wc * 32 + 8 * fq;
        float rsv[8]; PG8_RS8(ssq, u, row0, rsv, slot, last_pm);
#pragma unroll
        for (int ai = 0; ai < 2; ++ai)
#pragma unroll
            for (int m = 0; m < 4; ++m) { const int row = row0 + ai * HALF + m * 16; const float rs = rsv[ai * 4 + m];
                u32x4 w; unsigned wv[4];
#pragma unroll
                for (int n = 0; n < 2; ++n) { const f32x4 g = acc[ai][0][m][n] * rs, up = acc[ai][1][m][n] * rs;
                    const float h0 = silu_f(g[0]) * up[0], h1 = silu_f(g[1]) * up[1], h2 = silu_f(g[2]) * up[2], h3 = silu_f(g[3]) * up[3];
                    wv[2 * n] = pk2(h0, h1); wv[2 * n + 1] = pk2(h2, h3); }
                w.x = wv[0]; w.y = wv[1]; w.z = wv[2]; w.w = wv[3];
                *(u32x4*)(H + (size_t)row * ldh + col0) = w; }
    }
};
struct EpiRes {
    static constexpr bool PERM = true, AFTER_DRAIN = false;
    bf16_t* xb; float* ssq_out; float scale;
    __device__ __forceinline__ void operator()(const f32x4 (&acc)[2][2][4][2], const Unit& u, int wr, int wc, int fr, int fq) const {
        const unsigned row0 = u.pm * BM + wr * 64 + fr, col0 = u.pn * BM + wc * 32 + 8 * fq;
#pragma unroll
        for (int ai = 0; ai < 2; ++ai)
#pragma unroll
            for (int m = 0; m < 4; ++m) { const unsigned row = row0 + ai * HALF + m * 16; const unsigned off = row * 1024u + col0; float s = 0.f;
                const u32x4 bv0 = *(const u32x4*)(xb + off), bv1 = *(const u32x4*)(xb + off + HALF);
#pragma unroll
                for (int bj = 0; bj < 2; ++bj) { const u32x4 bv = bj ? bv1 : bv0;
                    const f32x4 b0 = {__uint_as_float(bv.x << 16), __uint_as_float(bv.x & 0xffff0000u), __uint_as_float(bv.y << 16), __uint_as_float(bv.y & 0xffff0000u)};
                    const f32x4 b1 = {__uint_as_float(bv.z << 16), __uint_as_float(bv.z & 0xffff0000u), __uint_as_float(bv.w << 16), __uint_as_float(bv.w & 0xffff0000u)};
                    const f32x4 v0 = b0 + acc[ai][bj][m][0] * scale, v1 = b1 + acc[ai][bj][m][1] * scale;
                    u32x4 w; w.x = pk2(v0[0], v0[1]); w.y = pk2(v0[2], v0[3]); w.z = pk2(v1[0], v1[1]); w.w = pk2(v1[2], v1[3]);
                    *(u32x4*)(xb + off + bj * HALF) = w;
                    s += (v0[0] * v0[0] + v0[1] * v0[1]) + (v0[2] * v0[2] + v0[3] * v0[3]) + (v1[0] * v1[0] + v1[1] * v1[1]) + (v1[2] * v1[2] + v1[3] * v1[3]); }
                s += __shfl_xor(s, 16); s += __shfl_xor(s, 32);
                if (fq == 0) ssq_out[(size_t)row * 16 + u.pn * 4 + wc] = s;
                asm volatile("" ::: "memory"); }
    }
};
struct EpiProj {
    static constexpr bool PERM = true, AFTER_DRAIN = false;
    bf16_t* P; const float* ssq; int ldp; PG8_LAS unsigned char* slot; const float* lb; mutable int last_pm;
    __device__ __forceinline__ void operator()(const f32x4 (&acc)[2][2][4][2], const Unit& u, int wr, int wc, int fr, int fq) const {
        const int row0 = u.pm * BM + wr * 64 + fr, col0 = u.pn * BM + wc * 32 + 8 * fq;
        float rsv[8]; PG8_RS8(ssq, u, row0, rsv, slot, last_pm);
        const bool fgate = (u.pn == 7) || (u.pn == 8);
        f32x4 lbv[2][2];
        if (fgate) {
#pragma unroll
            for (int bj = 0; bj < 2; ++bj) { lbv[bj][0] = *(const f32x4*)(lb + col0 - 1792 + bj * HALF); lbv[bj][1] = *(const f32x4*)(lb + col0 - 1792 + bj * HALF + 4); } }
        const bool act = (u.pn < 2) || (u.pn == 5) || (u.pn == 6) || (u.pn == 11) || (u.pn == 12);
#pragma unroll
        for (int ai = 0; ai < 2; ++ai)
#pragma unroll
            for (int m = 0; m < 4; ++m) { const int row = row0 + ai * HALF + m * 16; const float rs = rsv[ai * 4 + m];
                bf16_t* rowp = P + (size_t)row * ldp + col0;
#pragma unroll
                for (int bj = 0; bj < 2; ++bj) { f32x4 v0 = acc[ai][bj][m][0] * rs, v1 = acc[ai][bj][m][1] * rs;
                    if (act) {
#pragma unroll
                        for (int j = 0; j < 4; ++j) { v0[j] = silu_f(v0[j]); v1[j] = silu_f(v1[j]); } }
                    if (fgate) {
#pragma unroll
                        for (int j = 0; j < 4; ++j) {
                            const float e0 = fminf(__expf(-v0[j]), 1e30f), s0 = __builtin_amdgcn_rcpf(1.0f + e0), e1 = fminf(__expf(-v1[j]), 1e30f), s1 = __builtin_amdgcn_rcpf(1.0f + e1);
                            v0[j] = __log2f(lbv[bj][0][j] + (1.0f - lbv[bj][0][j]) * s0); v1[j] = __log2f(lbv[bj][1][j] + (1.0f - lbv[bj][1][j]) * s1); } }
                    u32x4 w; w.x = pk2(v0[0], v0[1]); w.y = pk2(v0[2], v0[3]); w.z = pk2(v1[0], v1[1]); w.w = pk2(v1[2], v1[3]);
                    *(u32x4*)(rowp + bj * HALF) = w; } }
    }
};

template <class Epi, class Sched, bool ALIGN_EPI = false, bool SP2 = false>
__device__ __forceinline__ void gemm_phase(PG8_LAS unsigned char* lds, const Gemm g, const Sched& S, const Epi& E) {
    int tid_l = threadIdx.x; asm volatile("" : "+v"(tid_l));
    const int tid = tid_l, wid = __builtin_amdgcn_readfirstlane(tid >> 6), lane = tid & 63, wr = wid >> 2, wc = wid & 3, fr = lane & 15, fq = lane >> 4;
    const int K = g.K, nt = K / BK;
    unsigned voffA[2], voffB[2];
#pragma unroll
    for (int i = 0; i < 2; ++i) { int R, C; stage_rc(tid * 16 + i * 8192, R, C); const int Rb = Epi::PERM ? ((R & ~31) + perm32(R & 31)) : R;
        voffA[i] = (unsigned)(R * K + C) * 2u; voffB[i] = (unsigned)(Rb * K + C) * 2u; }
    const size_t kstep = (size_t)(BK * 2);
    const size_t hstep = (size_t)HALF * K * 2;
    const size_t tstep = 2 * hstep;
    const unsigned ldsw = (unsigned)wid * 1024u;
    const int aoff = lds_byte(wr * 64 + fr, fq * 8), boff = lds_byte(wc * 32 + fr, fq * 8);
#define PG8_SA(b, h) (((b) * 2 + (h)) * HTB)
#define PG8_SB(b, h) ((4 + (b) * 2 + (h)) * HTB)
#define PG8_STAGE(bufoff, gbase, voff) do { _Pragma("unroll") for (int _i = 0; _i < 2; ++_i) \
        __builtin_amdgcn_global_load_lds((const unsigned*)((const char*)(gbase) + (voff)[_i]), (PG8_LAS unsigned*)(lds + (bufoff) + ldsw + _i * 8192), 16, 0, 0); } while (0)
#define PG8_LDA(dst, b, h) do { _Pragma("unroll") for (int m = 0; m < 4; ++m) _Pragma("unroll") for (int k = 0; k < 2; ++k) dst[m][k] = *(const PG8_LAS bf16x8*)(lds + PG8_SA(b, h) + aoff + m * 2048 + k * 1024); } while (0)
#define PG8_LDB(dst, b, h) do { _Pragma("unroll") for (int n = 0; n < 2; ++n) _Pragma("unroll") for (int k = 0; k < 2; ++k) dst[n][k] = *(const PG8_LAS bf16x8*)(lds + PG8_SB(b, h) + boff + n * 2048 + k * 1024); } while (0)
#define PG8_MMA(ai, bj, At, Bt) do { __builtin_amdgcn_s_setprio(1); _Pragma("unroll") for (int m = 0; m < 4; ++m) _Pragma("unroll") for (int n = 0; n < 2; ++n) _Pragma("unroll") for (int k = 0; k < 2; ++k) \
        acc[ai][bj][m][n] = __builtin_amdgcn_mfma_f32_16x16x32_bf16(Bt[n][k], At[m][k], acc[ai][bj][m][n], 0, 0, 0); __builtin_amdgcn_s_setprio(0); } while (0)
#define PG8_WAIT_V(n) asm volatile("s_waitcnt vmcnt(" #n ")" ::: "memory")
#define PG8_WAIT_L(n) asm volatile("s_waitcnt lgkmcnt(" #n ")" ::: "memory")
#define PG8_BAR __builtin_amdgcn_s_barrier()
#define PG8_SCHED __builtin_amdgcn_sched_barrier(0)
    Unit cur, nxt; int ui = 0;
    if (!S.next(0, cur)) return;
    f32x4 acc[2][2][4][2];
#pragma unroll
    for (int a = 0; a < 2; ++a)
#pragma unroll
        for (int b = 0; b < 2; ++b)
#pragma unroll
            for (int m = 0; m < 4; ++m)
#pragma unroll
                for (int n = 0; n < 2; ++n) acc[a][b][m][n] = (f32x4){0.f, 0.f, 0.f, 0.f};
    bf16x8 At[4][2], B0[2][2], B1[2][2];
    const char* cA = (const char*)g.A + (size_t)cur.pm * tstep; const char* cB = (const char*)g.Bt + (size_t)cur.pn * tstep;
    S.a_ready(cur);
    if constexpr (SP2) {
        PG8_STAGE(PG8_SB(0, 0), cB, voffB); PG8_STAGE(PG8_SB(0, 1), cB + hstep, voffB); PG8_STAGE(PG8_SA(0, 0), cA, voffA); PG8_STAGE(PG8_SA(0, 1), cA + hstep, voffA);
        if (wr == 1) PG8_BAR;
        PG8_WAIT_V(2); PG8_BAR;
        PG8_STAGE(PG8_SB(1, 0), cB + kstep, voffB); PG8_STAGE(PG8_SA(1, 0), cA + kstep, voffA); PG8_STAGE(PG8_SB(1, 1), cB + hstep + kstep, voffB);
        PG8_WAIT_V(6); PG8_BAR;
    } else {
        PG8_STAGE(PG8_SB(0, 0), cB, voffB); PG8_STAGE(PG8_SA(0, 0), cA, voffA); PG8_STAGE(PG8_SB(0, 1), cB + hstep, voffB); PG8_STAGE(PG8_SA(0, 1), cA + hstep, voffA);
        if (wr == 1) PG8_BAR;
        PG8_WAIT_V(4); PG8_BAR;
        PG8_STAGE(PG8_SB(1, 0), cB + kstep, voffB); PG8_STAGE(PG8_SA(1, 0), cA + kstep, voffA); PG8_STAGE(PG8_SB(1, 1), cB + hstep + kstep, voffB);
        PG8_WAIT_V(6); PG8_BAR;
    }
    for (;;) {
        const bool has_next = S.next(ui + 1, nxt);
        const char* nA = has_next ? (const char*)g.A + (size_t)nxt.pm * tstep : cA; const char* nB = has_next ? (const char*)g.Bt + (size_t)nxt.pn * tstep : cB;
        for (int t = 0; t < nt; t += 2) {
            const bool last = (t == nt - 2);
            const char* a1 = cA + (size_t)(t + 1) * kstep;
            const char* a2 = last ? nA : cA + (size_t)(t + 2) * kstep; const char* b2 = last ? nB : cB + (size_t)(t + 2) * kstep;
            const char* a3 = a2 + kstep; const char* b3 = b2 + kstep;
            if (last && has_next) S.a_ready(nxt);
            if constexpr (SP2) {
            PG8_LDB(B0, 0, 0); PG8_LDB(B1, 0, 1); PG8_SCHED; PG8_LDA(At, 0, 0); PG8_STAGE(PG8_SA(1, 1), a1 + hstep, voffA);
            PG8_WAIT_V(8); PG8_WAIT_L(0); PG8_BAR; PG8_MMA(0, 0, At, B0); PG8_MMA(0, 1, At, B1); PG8_BAR; PG8_SCHED;
            PG8_LDA(At, 0, 1); PG8_STAGE(PG8_SB(0, 0), b2, voffB); PG8_STAGE(PG8_SB(0, 1), b2 + hstep, voffB); PG8_STAGE(PG8_SA(0, 0), a2, voffA);
            PG8_WAIT_V(8); PG8_WAIT_L(0); PG8_BAR; PG8_MMA(1, 0, At, B0); PG8_MMA(1, 1, At, B1); PG8_BAR; PG8_SCHED;
            PG8_LDB(B0, 1, 0); PG8_LDB(B1, 1, 1); PG8_SCHED; PG8_LDA(At, 1, 0); PG8_STAGE(PG8_SA(0, 1), a2 + hstep, voffA);
            PG8_WAIT_V(8); PG8_WAIT_L(0); PG8_BAR; PG8_MMA(0, 0, At, B0); PG8_MMA(0, 1, At, B1); PG8_BAR; PG8_SCHED;
            PG8_LDA(At, 1, 1); PG8_STAGE(PG8_SB(1, 0), b3, voffB); PG8_STAGE(PG8_SB(1, 1), b3 + hstep, voffB); PG8_STAGE(PG8_SA(1, 0), a3, voffA);
            PG8_WAIT_V(8); PG8_WAIT_L(0); PG8_BAR; PG8_MMA(1, 0, At, B0); PG8_MMA(1, 1, At, B1); PG8_BAR; PG8_SCHED;
            } else {
            PG8_LDB(B0, 0, 0); PG8_SCHED; PG8_LDA(At, 0, 0); PG8_STAGE(PG8_SA(1, 1), a1 + hstep, voffA);
            PG8_WAIT_L(8); PG8_BAR; PG8_WAIT_L(0); PG8_MMA(0, 0, At, B0); PG8_BAR; PG8_SCHED;
            PG8_LDB(B1, 0, 1); PG8_STAGE(PG8_SB(0, 0), b2, voffB);
            PG8_BAR; PG8_WAIT_L(0); PG8_MMA(0, 1, At, B1); PG8_BAR;
            PG8_LDA(At, 0, 1); PG8_STAGE(PG8_SA(0, 0), a2, voffA);
            PG8_BAR; PG8_WAIT_L(0); PG8_MMA(1, 0, At, B0); PG8_BAR; PG8_SCHED;
            PG8_STAGE(PG8_SB(0, 1), b2 + hstep, voffB);
            PG8_WAIT_V(6); PG8_BAR; PG8_MMA(1, 1, At, B1); PG8_BAR;
            PG8_LDB(B0, 1, 0); PG8_SCHED; PG8_LDA(At, 1, 0); PG8_STAGE(PG8_SA(0, 1), a2 + hstep, voffA);
            PG8_WAIT_L(8); PG8_BAR; PG8_WAIT_L(0); PG8_MMA(0, 0, At, B0); PG8_BAR; PG8_SCHED;
            PG8_LDB(B1, 1, 1); PG8_STAGE(PG8_SB(1, 0), b3, voffB);
            PG8_BAR; PG8_WAIT_L(0); PG8_MMA(0, 1, At, B1); PG8_BAR;
            PG8_LDA(At, 1, 1); PG8_STAGE(PG8_SA(1, 0), a3, voffA);
            PG8_BAR; PG8_WAIT_L(0); PG8_MMA(1, 0, At, B0); PG8_BAR; PG8_SCHED;
            PG8_STAGE(PG8_SB(1, 1), b3 + hstep, voffB);
            PG8_WAIT_V(6); PG8_BAR; PG8_MMA(1, 1, At, B1); PG8_BAR;
            }
        }
        if constexpr (ALIGN_EPI) { if (wr == 0) PG8_BAR; }
        if constexpr (!Epi::AFTER_DRAIN) { E(acc, cur, wr, wc, fr, fq); S.done(cur); }
        if (!has_next) break;
#pragma unroll
        for (int a = 0; a < 2; ++a)
#pragma unroll
            for (int b = 0; b < 2; ++b)
#pragma unroll
                for (int m = 0; m < 4; ++m)
#pragma unroll
                    for (int n = 0; n < 2; ++n) acc[a][b][m][n] = (f32x4){0.f, 0.f, 0.f, 0.f};
        cur = nxt; cA = nA; cB = nB; ++ui;
        if constexpr (ALIGN_EPI) { if (wr == 1) PG8_BAR; }
    }
    PG8_WAIT_V(0);
    if constexpr (!ALIGN_EPI) { if (wr == 0) PG8_BAR; }
    PG8_BAR;
    if constexpr (Epi::AFTER_DRAIN) { E.fused(acc, cur, wr, wc, fr, fq, lds, wid, lane); S.done(cur); }
#undef PG8_SA
#undef PG8_SB
#undef PG8_STAGE
#undef PG8_LDA
#undef PG8_LDB
#undef PG8_MMA
#undef PG8_WAIT_V
#undef PG8_WAIT_L
#undef PG8_BAR
#undef PG8_SCHED
}
}

#define DI __device__ __forceinline__
#define LAS __attribute__((address_space(3)))
typedef unsigned short bf16_t;
typedef short bf16x8 __attribute__((ext_vector_type(8)));
typedef short s16x4 __attribute__((ext_vector_type(4)));
typedef float f32x4 __attribute__((ext_vector_type(4)));
typedef unsigned u32x4 __attribute__((ext_vector_type(4)));
typedef unsigned u32x2 __attribute__((ext_vector_type(2)));
using pg8::pk2; using pg8::silu_f;

constexpr int NWAVES = 8, NTHR = 512;
constexpr int M = 65536, D = 1024, FF = 2816, NGU = 2 * FF, PL = 3584, SEQ = 2048, DEPTH = 4, DPROJ = 3336;
constexpr int LDS_BYTES = 131072 + 256 + 16384, MISC_OFF = 131072, RSC_OFF = 131072 + 256;
constexpr size_t MiB = 1u << 20;
constexpr size_t WS_SSQ = 880 * MiB;
constexpr size_t WS_LB = 5 * MiB;
constexpr size_t WS_W = 8 * MiB;
constexpr size_t W_GU1 = 0, W_D1 = 11 * MiB, W_IN = W_D1 + 11 * MiB / 2, W_OUT = W_IN + 7 * MiB, W_GU2 = W_OUT + 2 * MiB, W_D2 = W_GU2 + 11 * MiB, W_LAYER = 42 * MiB;
static_assert(W_D2 + 11 * MiB / 2 == W_LAYER, "weight map");
constexpr size_t WS_XB = 176 * MiB;
constexpr size_t WS_Y = 304 * MiB;
constexpr size_t WS_R = 432 * MiB;
constexpr size_t WS_DTA = 932 * MiB;
constexpr size_t WS_EBV = 948 * MiB;
constexpr size_t WS_END = 956 * MiB;
static_assert(WS_W + 4 * W_LAYER == WS_XB && WS_R + (size_t)M * PL * 2 == WS_SSQ && WS_SSQ + 13 * 4 * MiB == WS_DTA, "ws map");

DI float bf2f(unsigned short h) { return __uint_as_float((unsigned)h << 16); }
DI float wave_sum(float v) {
#pragma unroll
    for (int o = 1; o < 64; o <<= 1) v += __shfl_xor(v, o);
    return v;
}
#define LDS_WAIT() asm volatile("s_waitcnt lgkmcnt(0)" ::: "memory")
DI f32x4 mma(bf16x8 a, bf16x8 b, f32x4 c) { return __builtin_amdgcn_mfma_f32_16x16x32_bf16(a, b, c, 0, 0, 0); }
DI bf16x8 pack8(f32x4 a, f32x4 b) { u32x4 w; w.x = pk2(a[0], a[1]); w.y = pk2(a[2], a[3]); w.z = pk2(b[0], b[1]); w.w = pk2(b[2], b[3]); return __builtin_bit_cast(bf16x8, w); }
constexpr int LS = 144;
DI bf16x8 ld_perm(const LAS unsigned char* base, int row, int kk, int q) {
    const LAS unsigned char* p = base + row * LS + kk * 64 + q * 8;
    const s16x4 lo = *(const LAS s16x4*)p, hi = *(const LAS s16x4*)(p + 32);
    return __builtin_shufflevector(lo, hi, 0, 1, 2, 3, 4, 5, 6, 7);
}
DI bf16x8 scale8(bf16x8 x, f32x4 wlo, f32x4 whi) {
    const u32x4 u = __builtin_bit_cast(u32x4, x);
    f32x4 a, b;
    a[0] = __uint_as_float(u.x << 16) * wlo[0]; a[1] = __uint_as_float(u.x & 0xffff0000u) * wlo[1];
    a[2] = __uint_as_float(u.y << 16) * wlo[2]; a[3] = __uint_as_float(u.y & 0xffff0000u) * wlo[3];
    b[0] = __uint_as_float(u.z << 16) * whi[0]; b[1] = __uint_as_float(u.z & 0xffff0000u) * whi[1];
    b[2] = __uint_as_float(u.w << 16) * whi[2]; b[3] = __uint_as_float(u.w & 0xffff0000u) * whi[3];
    return pack8(a, b);
}

#define XB_TMO      128
#define XB_XCNT(j)  (256  + 64 * (j))
#define XB_XSUB(j)  (1280 + 64 * (j))
#define XB_XGEN(j)  (2304 + 64 * (j))
#define XB_TOP      3328
#define XB_TOPGEN   3392
#define XCD_BAR_WORDS 3456
#define XB_SPIN_CAP (1u << 18)

__device__ __forceinline__ unsigned xb_ld(unsigned* p)              { return __hip_atomic_load(p, __ATOMIC_RELAXED, __HIP_MEMORY_SCOPE_AGENT); }
__device__ __forceinline__ unsigned xb_add(unsigned* p, unsigned v) { return __hip_atomic_fetch_add(p, v, __ATOMIC_RELAXED, __HIP_MEMORY_SCOPE_AGENT); }
__device__ __forceinline__ unsigned xb_xcc_id() { return (unsigned)__builtin_amdgcn_s_getreg((3 << 11) | 20) & 0xFu; }
#define XB_SPIN(cond, bar) do { unsigned _sp = 0; while (cond) { __builtin_amdgcn_s_sleep(1); \
    if ((++_sp & 255u) == 0u) { if (xb_ld(&(bar)[XB_TMO])) break; if (_sp > XB_SPIN_CAP) { atomicAdd(&(bar)[XB_TMO], 1u); break; } } } } while (0)

struct XcdBarrier {
    unsigned* bar; unsigned x;
    volatile LAS unsigned* st;
};

__device__ __forceinline__ XcdBarrier xcd_barrier_post(unsigned* bar, volatile LAS unsigned* st) {
    XcdBarrier b; b.bar = bar; b.x = xb_xcc_id(); b.st = st;
    if (threadIdx.x == 0) (void)xb_add(&bar[XB_XCNT(b.x)], 1u);
    return b;
}
__device__ __forceinline__ void xcd_barrier_complete(unsigned* bar, unsigned x, unsigned& nloc, unsigned& nx) {
    const unsigned G = gridDim.x * gridDim.y * gridDim.z;
    unsigned sum, cnt, mine, sp = 0u;
    for (;;) {
        sum = 0u; cnt = 0u; mine = 0u;
#pragma unroll
        for (unsigned j = 0; j < 16; ++j) { const unsigned c = xb_ld(&bar[XB_XCNT(j)]); sum += c; cnt += (c > 0u) ? 1u : 0u; mine = (j == x) ? c : mine; }
        if (sum == G) break;
        __builtin_amdgcn_s_sleep(1);
        if ((++sp & 255u) == 0u) { if (xb_ld(&bar[XB_TMO])) break; if (sp > XB_SPIN_CAP) { atomicAdd(&bar[XB_TMO], 1u); break; } }
    }
    nloc = mine > 0u ? mine : 1u; nx = cnt > 0u ? cnt : 1u;
}

__device__ __forceinline__ void xcd_barrier(const XcdBarrier& b) {
    asm volatile("s_waitcnt vmcnt(0)" ::: "memory");
    __syncthreads();
    if (threadIdx.x == 0) {
        unsigned* bar = b.bar;
        __builtin_amdgcn_s_waitcnt(0);
        unsigned nloc = b.st[0], nx = b.st[1];
        if (nloc == 0u) { xcd_barrier_complete(bar, b.x, nloc, nx); b.st[0] = nloc; b.st[1] = nx; }
        const unsigned old = xb_add(&bar[XB_XSUB(b.x)], 1u);
        const unsigned gen = old / nloc;
        if (old + 1u == (gen + 1u) * nloc) {
            __builtin_amdgcn_fence(__ATOMIC_RELEASE, "agent");
            asm volatile("s_waitcnt vmcnt(0)" ::: "memory");
            const unsigned og = xb_add(&bar[XB_TOP], 1u);
            const unsigned tg = og / nx;
            if (og + 1u == (tg + 1u) * nx) xb_add(&bar[XB_TOPGEN], 1u);
            else XB_SPIN(xb_ld(&bar[XB_TOPGEN]) == tg, bar);
            __builtin_amdgcn_fence(__ATOMIC_ACQUIRE, "agent");
            xb_add(&bar[XB_XGEN(b.x)], 1u);
            asm volatile("s_waitcnt vmcnt(0)" ::: "memory");
        } else {
            XB_SPIN(xb_ld(&bar[XB_XGEN(b.x)]) == gen, bar);
            __builtin_amdgcn_fence(__ATOMIC_ACQUIRE, "agent");
            asm volatile("s_waitcnt vmcnt(0)" ::: "memory");
        }
    }
    __syncthreads();
}

DI void p0_item(const float* W, int ldsrc, int k0, int src_col0, int nvalid, const float* normw, bf16_t* WT, int ldk, int dst_row0, LAS float* scr, int lane) {
    const int c = lane & 31;
#pragma unroll
    for (int i = 0; i < 32; ++i) { const int kk = 2 * i + (lane >> 5);
        float v = (c < nvalid) ? W[(size_t)(k0 + kk) * ldsrc + src_col0 + c] : 0.f;
        if (normw) v *= normw[k0 + kk];
        scr[kk * 33 + c] = v; }
    LDS_WAIT(); asm volatile("" ::: "memory");
    const int c8 = lane & 7;
#pragma unroll
    for (int j = 0; j < 4; ++j) { const int n = (lane >> 3) + 8 * j; const LAS float* s = scr + (8 * c8) * 33 + n;
        u32x4 o; o.x = pk2(s[0 * 33], s[1 * 33]); o.y = pk2(s[2 * 33], s[3 * 33]); o.z = pk2(s[4 * 33], s[5 * 33]); o.w = pk2(s[6 * 33], s[7 * 33]);
        *(u32x4*)(WT + (size_t)(dst_row0 + n) * ldk + k0 + 8 * c8) = o; }
    LDS_WAIT(); asm volatile("" ::: "memory");
}

struct Args { const float* in[21]; float* out; unsigned char* ws; };

DI void convert_layer(const Args& a, int l, LAS unsigned char* lds, int gw, int NGW, int lane_in, int wave) {
    int lane = lane_in; asm volatile("" : "+v"(lane));
    unsigned char* ws = a.ws;
    LAS float* scr = (LAS float*)(lds + wave * 16384);
    constexpr int I_GU = (NGU / 32) * (D / 64), I_D = (D / 32) * (FF / 64), I_IN = (PL / 32) * (D / 64), I_OUT = (D / 32) * (D / 64);
    constexpr int I_LAYER = 2 * I_GU + 2 * I_D + I_IN + I_OUT;
    unsigned char* wl = ws + WS_W + (size_t)l * W_LAYER;
    for (int it = gw; it < I_LAYER; it += NGW) {
        int r = it;
        int which = 0;
        if (r >= I_GU) { r -= I_GU; which = 1; if (r >= I_D) { r -= I_D; which = 2; if (r >= I_IN) { r -= I_IN; which = 3; if (r >= I_OUT) { r -= I_OUT; which = 4; if (r >= I_GU) { r -= I_GU; which = 5; } } } } }
        if (which == 0 || which == 4) {
            const int nblk = NGU / 32, kb = r / nblk, nb = r % nblk, pn = nb >> 3, j = nb & 7;
            const float* src = (j < 4) ? a.in[which == 0 ? 2 : 17] : a.in[which == 0 ? 3 : 18];
            const float* nw = a.in[which == 0 ? 1 : 16] + (size_t)l * D;
            p0_item(src + (size_t)l * D * FF, FF, 64 * kb, 128 * pn + 32 * (j & 3), 32, nw, (bf16_t*)(wl + (which == 0 ? W_GU1 : W_GU2)), D, 32 * nb, scr, lane);
        } else if (which == 1 || which == 5) {
            const int nblk = D / 32, kb = r / nblk, nb = r % nblk;
            p0_item(a.in[which == 1 ? 4 : 19] + (size_t)l * FF * D, D, 64 * kb, 32 * nb, 32, nullptr, (bf16_t*)(wl + (which == 1 ? W_D1 : W_D2)), FF, 32 * nb, scr, lane);
        } else if (which == 2) {
            const int nblk = PL / 32, kb = r / nblk, nb = r % nblk;
            int sc, nv;
            if (nb < 40) { sc = 32 * nb; nv = 32; } else if (nb < 104) { sc = 32 * nb + 8; nv = 32; } else if (nb == 104) { sc = 1280; nv = 8; } else { sc = 0; nv = 0; }
            p0_item(a.in[6] + (size_t)l * D * DPROJ, DPROJ, 64 * kb, sc, nv, a.in[5] + (size_t)l * D, (bf16_t*)(wl + W_IN), D, 32 * nb, scr, lane);
        } else {
            const int nblk = D / 32, kb = r / nblk, nb = r % nblk;
            p0_item(a.in[15] + (size_t)l * D * D, D, 64 * kb, 32 * nb, 32, nullptr, (bf16_t*)(wl + W_OUT), D, 32 * nb, scr, lane);
        }
    }
}

DI void prologue(const Args& a, LAS unsigned char* lds, int gw, int NGW, int lane, int wave) {
    unsigned char* ws = a.ws;
    if (blockIdx.x == 0) { const int c = threadIdx.x; const float* lg = a.in[13];
        const float x0 = lg[c], x1 = lg[512 + c], x2 = lg[1024 + c], x3 = lg[1536 + c]; const float mx = fmaxf(fmaxf(x0, x1), fmaxf(x2, x3));
        const float e0 = __expf(x0 - mx), e1 = __expf(x1 - mx), e2 = __expf(x2 - mx), e3 = __expf(x3 - mx); const float inv = 1.0f / (e0 + e1 + e2 + e3);
        float* LB = (float*)(ws + WS_LB); LB[c] = 0.f; LB[512 + c] = e1 * inv; LB[1024 + c] = (e1 + e2) * inv; LB[1536 + c] = (e1 + e2 + e3) * inv; }
    { const float* x = a.in[0]; bf16_t* XB = (bf16_t*)(ws + WS_XB); float* ssq0 = (float*)(ws + WS_SSQ);
      for (int m0 = gw; m0 < M; m0 += 2 * NGW) { f32x4 v[2][4];
#pragma unroll
          for (int h = 0; h < 2; ++h) { const int m = m0 + h * NGW; const f32x4* xr = (const f32x4*)(x + (size_t)m * D) + lane;
#pragma unroll
              for (int j = 0; j < 4; ++j) v[h][j] = xr[64 * j]; }
#pragma unroll
          for (int h = 0; h < 2; ++h) { const int m = m0 + h * NGW; float s = 0.f;
#pragma unroll
              for (int j = 0; j < 4; ++j) s += (v[h][j].x * v[h][j].x + v[h][j].y * v[h][j].y) + (v[h][j].z * v[h][j].z + v[h][j].w * v[h][j].w);
              s = wave_sum(s);
              u32x2* o8 = (u32x2*)(XB + (size_t)m * D) + lane;
#pragma unroll
              for (int j = 0; j < 4; ++j) { u32x2 w; w.x = pk2(v[h][j].x, v[h][j].y); w.y = pk2(v[h][j].z, v[h][j].w); o8[64 * j] = w; }
              if (lane < 16) ssq0[(size_t)m * 16 + lane] = (lane == 0) ? s : 0.f; } } }
    convert_layer(a, 0, lds, gw, NGW, lane, wave);
}

struct MixL { bf16_t* proj; bf16_t* Y; bf16_t* XA; float* DTA; float* EBV; const float *conv_w, *conv_b, *dt_bias, *a_log, *dskip, *ssd_nw, *lb, *hg_nw; };


constexpr int SSD_STG = 73728, SSD_DT2 = 122880;
DI void ssd_dma(LAS unsigned char* lds, const MixL& P, size_t rowbase, int b, int g, int c, int tid, int wave) {
    const int t0 = c * 64;
    { const int cgi = tid & 31, run = tid >> 5;
      const int c0 = 256 * g + 8 * cgi;
#pragma unroll
      for (int j = 0; j < 4; ++j) __builtin_amdgcn_global_load_lds((const unsigned*)(P.XA + (rowbase + t0 + 4 * run + j) * 768 + c0), (LAS unsigned*)(lds + SSD_STG + j * 8192 + wave * 1024), 16, 0, 0); }
    if (wave < 4) { const int run = (tid & 127) >> 3;
      const int c0 = (wave < 2 ? 512 : 640) + 64 * g + 8 * (tid & 7);
#pragma unroll
      for (int j = 0; j < 4; ++j) __builtin_amdgcn_global_load_lds((const unsigned*)(P.XA + (rowbase + t0 + 4 * run + j) * 768 + c0), (LAS unsigned*)(lds + SSD_STG + 32768 + j * 4096 + wave * 1024), 16, 0, 0);
      __builtin_amdgcn_global_load_lds((const unsigned*)(P.DTA + (size_t)(b * 32 + c) * 2048 + wave * 512 + (4 * g + ((tid & 63) >> 4)) * 64 + 4 * (tid & 15)), (LAS unsigned*)(lds + SSD_DT2 + wave * 1024), 16, 0, 0); }
}
DI void ssd_unit(LAS unsigned char* lds, const MixL& P, int b, int g) {
    int tid_l = threadIdx.x; asm volatile("" : "+v"(tid_l));
    const int tid = tid_l, lane = tid & 63, wave = __builtin_amdgcn_readfirstlane(tid >> 6), l15 = lane & 15, q = lane >> 4;
    const int r = wave >> 1, hh = wave & 1;
    LAS unsigned char* XT = lds; LAS unsigned char* BMp = lds + 36864; LAS unsigned char* BTp = lds + 46080; LAS unsigned char* CMp = lds + 55296;
    LAS float* ACUM = (LAS float*)(lds + 64512); LAS float* DTV = ACUM + 256; LAS float* EA = ACUM + 512; LAS float* WV = ACUM + 768; LAS float* SSQP = ACUM + 1024;
    const float Dr = P.dskip[4 * g + r];
    const size_t rowbase = (size_t)b * SEQ;
    const int ycol = 256 * g + 64 * r + 32 * hh + 4 * q;
    const LAS unsigned char* XTr = XT + r * 64 * LS;
    const LAS float* ac = ACUM + r * 64; const LAS float* dtv = DTV + r * 64; const LAS float* ea = EA + r * 64; const LAS float* wv = WV + r * 64;
    f32x4 ST[4][2];
#pragma unroll
    for (int i = 0; i < 4; ++i)
#pragma unroll
        for (int j = 0; j < 2; ++j) ST[i][j] = (f32x4){0.f, 0.f, 0.f, 0.f};
    f32x4 nwv[2];
#pragma unroll
    for (int pt = 0; pt < 2; ++pt) nwv[pt] = *(const f32x4*)(P.ssd_nw + ycol + 16 * pt);
    ssd_dma(lds, P, rowbase, b, g, 0, tid, wave);
#pragma unroll 1
    for (int c = 0; c < SEQ / 64; ++c) {
        const int t0 = c * 64;
        asm volatile("s_waitcnt vmcnt(0)" ::: "memory");
#pragma unroll
        for (int pass = 0; pass < 2; ++pass) {
            if (pass == 0 || wave < 4) {
            const int cgi = pass ? (wave < 2 ? 32 : 40) + (tid & 7) : (tid & 31), run = pass ? ((tid & 127) >> 3) : (tid >> 5);
            u32x4 rv[4];
#pragma unroll
            for (int j = 0; j < 4; ++j) rv[j] = *(const LAS u32x4*)(lds + SSD_STG + (pass ? 32768 + j * 4096 : j * 8192) + tid * 16);
            u32x2 tv[8];
#pragma unroll
            for (int e = 0; e < 8; ++e) { const unsigned a0 = rv[0][e >> 1], a1 = rv[1][e >> 1], a2 = rv[2][e >> 1], a3 = rv[3][e >> 1];
                if (e & 1) { tv[e].x = (a0 >> 16) | (a1 & 0xffff0000u); tv[e].y = (a2 >> 16) | (a3 & 0xffff0000u); }
                else { tv[e].x = (a0 & 0xffffu) | (a1 << 16); tv[e].y = (a2 & 0xffffu) | (a3 << 16); } }
            if (cgi < 32) { const int rr = cgi >> 3, p0 = 8 * (cgi & 7);
#pragma unroll
                for (int e = 0; e < 8; ++e) *(LAS u32x2*)(XT + (rr * 64 + p0 + e) * LS + ((run ^ ((cgi & 1) | (((cgi >> 2) & 7) << 1))) << 3)) = tv[e];
            } else if (cgi < 40) { const int n0 = 8 * (cgi - 32);
#pragma unroll
                for (int j = 0; j < 4; ++j) *(LAS u32x4*)(BMp + (4 * run + j) * LS + n0 * 2) = rv[j];
#pragma unroll
                for (int e = 0; e < 8; ++e) *(LAS u32x2*)(BTp + (n0 + e) * LS + ((run ^ (cgi & 1)) << 3)) = tv[e];
            } else { const int n0 = 8 * (cgi - 40);
#pragma unroll
                for (int j = 0; j < 4; ++j) *(LAS u32x4*)(CMp + (4 * run + j) * LS + n0 * 2) = rv[j];
            }
            }
        }
        if (wave < 4) *(LAS u32x4*)(ACUM + 4 * tid) = *(const LAS u32x4*)(lds + SSD_DT2 + tid * 16);
        __syncthreads();
        u32x2 zr[2][4];
#pragma unroll
        for (int pt = 0; pt < 2; ++pt)
#pragma unroll
            for (int ti = 0; ti < 4; ++ti) zr[pt][ti] = *(const u32x2*)(P.proj + (rowbase + t0 + 16 * ti + l15) * PL + ycol + 16 * pt);
        if (c + 1 < SEQ / 64) ssd_dma(lds, P, rowbase, b, g, c + 1, tid, wave);
        bf16x8 bmp[4][2], cmp[4][2], xtp[2][2];
#pragma unroll
        for (int i = 0; i < 4; ++i)
#pragma unroll
            for (int kk = 0; kk < 2; ++kk) { bmp[i][kk] = ld_perm(BMp, 16 * i + l15, kk, q); cmp[i][kk] = ld_perm(CMp, 16 * i + l15, kk, q); }
#pragma unroll
        for (int pt = 0; pt < 2; ++pt)
#pragma unroll
            for (int kk = 0; kk < 2; ++kk) { const int gsw = (l15 >> 3) | (hh << 1) | (r << 2);
                const LAS unsigned char* pr_ = XTr + (32 * hh + 16 * pt + l15) * LS;
                const s16x4 lo_ = *(const LAS s16x4*)(pr_ + (((kk * 8 + q) ^ gsw) << 3)), hi_ = *(const LAS s16x4*)(pr_ + (((kk * 8 + q + 4) ^ gsw) << 3));
                xtp[pt][kk] = __builtin_shufflevector(lo_, hi_, 0, 1, 2, 3, 4, 5, 6, 7); }
        float at[4], eat[4]; f32x4 as4[4], ds4[4];
#pragma unroll
        for (int i = 0; i < 4; ++i) { at[i] = ac[16 * i + l15]; eat[i] = ea[16 * i + l15]; as4[i] = *(const LAS f32x4*)(ac + 16 * i + 4 * q); ds4[i] = *(const LAS f32x4*)(dtv + 16 * i + 4 * q); }
        const float eaend = ea[63];
        f32x4 y[2][4];
#pragma unroll
        for (int ti = 0; ti < 4; ++ti) {
            f32x4 lt[4];
#pragma unroll
            for (int sj = 0; sj < 4; ++sj) {
                if (sj <= ti) {
                    f32x4 ga = (f32x4){0.f, 0.f, 0.f, 0.f};
                    ga = mma(bmp[sj][0], cmp[ti][0], ga); ga = mma(bmp[sj][1], cmp[ti][1], ga);
#pragma unroll
                    for (int rr = 0; rr < 4; ++rr) { float v = ga[rr] * __builtin_amdgcn_exp2f(at[ti] - as4[sj][rr]) * ds4[sj][rr];
                        if (sj == ti) { const int sl = 4 * q + rr; v = (sl <= l15) ? v : 0.f; v = (sl == l15) ? v + Dr : v; }
                        lt[sj][rr] = v; }
                } else lt[sj] = (f32x4){0.f, 0.f, 0.f, 0.f};
            }
            const bf16x8 lf0 = pack8(lt[0], lt[1]), lf1 = pack8(lt[2], lt[3]);
#pragma unroll
            for (int pt = 0; pt < 2; ++pt) { f32x4 a = (f32x4){0.f, 0.f, 0.f, 0.f}; a = mma(xtp[pt][0], lf0, a); if (ti >= 2) a = mma(xtp[pt][1], lf1, a); y[pt][ti] = a; }
        }
#pragma unroll
        for (int pt = 0; pt < 2; ++pt) { const bf16x8 sf0 = pack8(ST[0][pt], ST[1][pt]), sf1 = pack8(ST[2][pt], ST[3][pt]);
#pragma unroll
            for (int ti = 0; ti < 4; ++ti) { f32x4 a = (f32x4){0.f, 0.f, 0.f, 0.f}; a = mma(sf0, cmp[ti][0], a); a = mma(sf1, cmp[ti][1], a); y[pt][ti] += a * eat[ti]; } }
        { bf16x8 xw[2][2];
#pragma unroll
          for (int kk = 0; kk < 2; ++kk) { const f32x4 wlo = *(const LAS f32x4*)(wv + 32 * kk + 4 * q), whi = *(const LAS f32x4*)(wv + 32 * kk + 16 + 4 * q);
#pragma unroll
              for (int pt = 0; pt < 2; ++pt) xw[pt][kk] = scale8(xtp[pt][kk], wlo, whi); }
#pragma unroll
          for (int nj = 0; nj < 4; ++nj) { const bf16x8 b0 = ld_perm(BTp, 16 * nj + l15, 0, q ^ (l15 >> 3)), b1 = ld_perm(BTp, 16 * nj + l15, 1, q ^ (l15 >> 3));
#pragma unroll
              for (int pt = 0; pt < 2; ++pt) { f32x4 a = ST[nj][pt] * eaend; a = mma(b0, xw[pt][0], a); a = mma(b1, xw[pt][1], a); ST[nj][pt] = a; } } }
        float sq[4] = {0.f, 0.f, 0.f, 0.f};
#pragma unroll
        for (int pt = 0; pt < 2; ++pt)
#pragma unroll
            for (int ti = 0; ti < 4; ++ti) { const u32x2 zz = zr[pt][ti];
                const float z0 = __uint_as_float(zz.x << 16), z1 = __uint_as_float(zz.x & 0xffff0000u), z2 = __uint_as_float(zz.y << 16), z3 = __uint_as_float(zz.y & 0xffff0000u);
                f32x4 v = y[pt][ti]; v[0] *= z0; v[1] *= z1; v[2] *= z2; v[3] *= z3; y[pt][ti] = v;
                sq[ti] += (v[0] * v[0] + v[1] * v[1]) + (v[2] * v[2] + v[3] * v[3]); }
#pragma unroll
        for (int ti = 0; ti < 4; ++ti) { float s = sq[ti]; s += __shfl_xor(s, 16); s += __shfl_xor(s, 32); if (q == 0) SSQP[wave * 64 + 16 * ti + l15] = s; }
        asm volatile("s_waitcnt lgkmcnt(0)" ::: "memory"); __builtin_amdgcn_s_barrier(); asm volatile("" ::: "memory");
#pragma unroll
        for (int ti = 0; ti < 4; ++ti) { float tot = 0.f;
#pragma unroll
            for (int w8 = 0; w8 < 8; ++w8) tot += SSQP[w8 * 64 + 16 * ti + l15];
            const float rs = __builtin_amdgcn_rsqf(tot * (1.0f / 256.0f) + pg8::RMS_EPS);
#pragma unroll
            for (int pt = 0; pt < 2; ++pt) { const f32x4 o = y[pt][ti] * rs * nwv[pt];
                u32x2 w2; w2.x = pk2(o[0], o[1]); w2.y = pk2(o[2], o[3]);
                *(u32x2*)(P.Y + (rowbase + t0 + 16 * ti + l15) * D + ycol + 16 * pt) = w2; } }
    }
}


constexpr int HG_STG = 81920;
DI void hg_dma(LAS unsigned char* lds, const MixL& P, size_t rowbase, int h, int c, int tid, int wave) {
    const int tc = tid & 255, cg = tc & 7, tp = tc >> 3;
    const bf16_t* pr = P.proj + (rowbase + c * 64 + 2 * tp) * PL + 64 * h + 8 * cg;
    __builtin_amdgcn_global_load_lds((const unsigned*)(pr + 1280), (LAS unsigned*)(lds + HG_STG + 0 * 8192 + wave * 1024), 16, 0, 0);
    __builtin_amdgcn_global_load_lds((const unsigned*)(pr + PL + 1280), (LAS unsigned*)(lds + HG_STG + 1 * 8192 + wave * 1024), 16, 0, 0);
    __builtin_amdgcn_global_load_lds((const unsigned*)(pr + 1792), (LAS unsigned*)(lds + HG_STG + 2 * 8192 + wave * 1024), 16, 0, 0);
    __builtin_amdgcn_global_load_lds((const unsigned*)(pr + PL + 1792), (LAS unsigned*)(lds + HG_STG + 3 * 8192 + wave * 1024), 16, 0, 0);
    __builtin_amdgcn_global_load_lds((const unsigned*)(pr + 2304), (LAS unsigned*)(lds + HG_STG + 4 * 8192 + wave * 1024), 16, 0, 0);
    __builtin_amdgcn_global_load_lds((const unsigned*)(pr + PL + 2304), (LAS unsigned*)(lds + HG_STG + 5 * 8192 + wave * 1024), 16, 0, 0);
}
DI void hg_unit(LAS unsigned char* lds, const MixL& P, int pi) {
    int tid_l = threadIdx.x; asm volatile("" : "+v"(tid_l));
    const int tid = tid_l, lane = tid & 63, wave = __builtin_amdgcn_readfirstlane(tid >> 6), l15 = lane & 15, q = lane >> 4;
    const int chain = wave >> 2, wv = wave & 3, ci = 2 * pi + chain, b = ci >> 3, h = ci & 7;
    LAS unsigned char* base = lds + chain * 40960;
    LAS unsigned char* QE = base; LAS unsigned char* KE = base + 9216; LAS unsigned char* KET = base + 18432; LAS unsigned char* VT = base + 27648;
    LAS float* EBREF = (LAS float*)(base + 36864); LAS float* EBLR = EBREF + 64; LAS float* EBLAST = EBREF + 128; LAS float* CUMQ = EBREF + 192; LAS float* SSQP = EBREF + 448;
    const int d = lane, tq = wv;
    const size_t rowbase = (size_t)b * SEQ;
    const int ycol = 64 * h + 16 * wv + 4 * q;
    f32x4 SD[4];
#pragma unroll
    for (int i = 0; i < 4; ++i) SD[i] = (f32x4){0.f, 0.f, 0.f, 0.f};
    const f32x4 nw = *(const f32x4*)(P.hg_nw + 16 * wv + 4 * q);
    hg_dma(lds, P, rowbase, h, 0, tid, wave);
#pragma unroll 1
    for (int c = 0; c < SEQ / 64; ++c) {
        const int t0 = c * 64;
        asm volatile("s_waitcnt vmcnt(0)" ::: "memory"); __syncthreads();
        float qv[16], kv[16], cs[16]; unsigned vv[8]; float runs = 0.f;
#pragma unroll
        for (int i = 0; i < 16; ++i) { const LAS unsigned char* sp = lds + HG_STG + (i & 1) * 8192 + (chain * 256 + (8 * tq + (i >> 1)) * 8 + (d >> 3)) * 16 + (d & 7) * 2;
            const float a = bf2f(*(const LAS unsigned short*)(sp + 2 * 8192)), qr = bf2f(*(const LAS unsigned short*)sp); const unsigned vb = *(const LAS unsigned short*)(sp + 4 * 8192);
            if (i & 1) vv[i >> 1] |= vb << 16; else vv[i >> 1] = vb;
            runs += a; cs[i] = runs; qv[i] = qr; kv[i] = 1.0f - __builtin_amdgcn_exp2f(a); }
        CUMQ[tq * 64 + d] = runs;
        __syncthreads();
        { const float c0 = CUMQ[d], c1 = CUMQ[64 + d], c2 = CUMQ[128 + d], c3 = CUMQ[192 + d];
          const float bref = c0 + c1, blast = bref + (c2 + c3);
          const float pre = (tq == 0) ? 0.f : (tq == 1 ? c0 : (tq == 2 ? bref : bref + c2));
          unsigned kt[8];
#pragma unroll
          for (int i = 0; i < 16; i += 2) { const float b0 = pre + cs[i], b1 = pre + cs[i + 1];
              const unsigned qp = pk2(qv[i] * __builtin_amdgcn_exp2f(b0 - bref), qv[i + 1] * __builtin_amdgcn_exp2f(b1 - bref)), kp = pk2(kv[i] * __builtin_amdgcn_exp2f(bref - b0), kv[i + 1] * __builtin_amdgcn_exp2f(bref - b1));
              *(LAS unsigned short*)(QE + (16 * tq + i) * LS + d * 2) = (unsigned short)(qp & 0xffffu); *(LAS unsigned short*)(QE + (16 * tq + i + 1) * LS + d * 2) = (unsigned short)(qp >> 16);
              *(LAS unsigned short*)(KE + (16 * tq + i) * LS + d * 2) = (unsigned short)(kp & 0xffffu); *(LAS unsigned short*)(KE + (16 * tq + i + 1) * LS + d * 2) = (unsigned short)(kp >> 16);
              kt[i >> 1] = kp; }
          *(LAS u32x4*)(KET + d * LS + tq * 32) = (u32x4){kt[0], kt[1], kt[2], kt[3]}; *(LAS u32x4*)(KET + d * LS + tq * 32 + 16) = (u32x4){kt[4], kt[5], kt[6], kt[7]};
          *(LAS u32x4*)(VT + d * LS + tq * 32) = (u32x4){vv[0], vv[1], vv[2], vv[3]}; *(LAS u32x4*)(VT + d * LS + tq * 32 + 16) = (u32x4){vv[4], vv[5], vv[6], vv[7]};
          if (tq == 0) { EBREF[d] = __builtin_amdgcn_exp2f(bref); EBLR[d] = __builtin_amdgcn_exp2f(blast - bref); EBLAST[d] = __builtin_amdgcn_exp2f(blast); } }
        __syncthreads();
        u32x2 gr[4];
#pragma unroll
        for (int ti = 0; ti < 4; ++ti) gr[ti] = *(const u32x2*)(P.proj + (rowbase + t0 + 16 * ti + l15) * PL + 2816 + ycol);
        if (c + 1 < SEQ / 64) hg_dma(lds, P, rowbase, h, c + 1, tid, wave);
        bf16x8 kep[4][2], qep[4][2], vtp[2];
#pragma unroll
        for (int i = 0; i < 4; ++i)
#pragma unroll
            for (int kk = 0; kk < 2; ++kk) { kep[i][kk] = ld_perm(KE, 16 * i + l15, kk, q); qep[i][kk] = ld_perm(QE, 16 * i + l15, kk, q); }
#pragma unroll
        for (int kk = 0; kk < 2; ++kk) vtp[kk] = ld_perm(VT, 16 * wv + l15, kk, q);
        f32x4 o[4];
#pragma unroll
        for (int ti = 0; ti < 4; ++ti) {
            f32x4 pt_[4];
#pragma unroll
            for (int sj = 0; sj < 4; ++sj) {
                if (sj <= ti) { f32x4 a = (f32x4){0.f, 0.f, 0.f, 0.f}; a = mma(kep[sj][0], qep[ti][0], a); a = mma(kep[sj][1], qep[ti][1], a);
                    if (sj == ti) {
#pragma unroll
                        for (int rr = 0; rr < 4; ++rr) a[rr] = (4 * q + rr <= l15) ? a[rr] : 0.f; }
                    pt_[sj] = a;
                } else pt_[sj] = (f32x4){0.f, 0.f, 0.f, 0.f};
            }
            const bf16x8 pf0 = pack8(pt_[0], pt_[1]), pf1 = pack8(pt_[2], pt_[3]);
            f32x4 a = (f32x4){0.f, 0.f, 0.f, 0.f}; a = mma(vtp[0], pf0, a); if (ti >= 2) a = mma(vtp[1], pf1, a); o[ti] = a;
        }
        { f32x4 er[4];
#pragma unroll
          for (int dj = 0; dj < 4; ++dj) er[dj] = *(const LAS f32x4*)(EBREF + 16 * dj + 4 * q);
          const bf16x8 sf0 = pack8(SD[0] * er[0], SD[1] * er[1]), sf1 = pack8(SD[2] * er[2], SD[3] * er[3]);
#pragma unroll
          for (int ti = 0; ti < 4; ++ti) { o[ti] = mma(sf0, qep[ti][0], o[ti]); o[ti] = mma(sf1, qep[ti][1], o[ti]); } }
#pragma unroll
        for (int dj = 0; dj < 4; ++dj) { f32x4 a = (f32x4){0.f, 0.f, 0.f, 0.f};
            a = mma(ld_perm(KET, 16 * dj + l15, 0, q), vtp[0], a); a = mma(ld_perm(KET, 16 * dj + l15, 1, q), vtp[1], a);
            const f32x4 el = *(const LAS f32x4*)(EBLAST + 16 * dj + 4 * q), elr = *(const LAS f32x4*)(EBLR + 16 * dj + 4 * q);
            SD[dj] = SD[dj] * el + a * elr; }
#pragma unroll
        for (int ti = 0; ti < 4; ++ti) { const f32x4 v = o[ti]; float s = (v[0] * v[0] + v[1] * v[1]) + (v[2] * v[2] + v[3] * v[3]); s += __shfl_xor(s, 16); s += __shfl_xor(s, 32);
            if (q == 0) SSQP[wv * 64 + 16 * ti + l15] = s; }
        asm volatile("s_waitcnt lgkmcnt(0)" ::: "memory"); __builtin_amdgcn_s_barrier(); asm volatile("" ::: "memory");
#pragma unroll
        for (int ti = 0; ti < 4; ++ti) { const float tot = (SSQP[16 * ti + l15] + SSQP[64 + 16 * ti + l15]) + (SSQP[128 + 16 * ti + l15] + SSQP[192 + 16 * ti + l15]);
            const float rs = __builtin_amdgcn_rsqf(tot * (1.0f / 64.0f) + pg8::RMS_EPS); const u32x2 gg = gr[ti];
            const float g0 = __uint_as_float(gg.x << 16), g1 = __uint_as_float(gg.x & 0xffff0000u), g2 = __uint_as_float(gg.y << 16), g3 = __uint_as_float(gg.y & 0xffff0000u);
            f32x4 ov = o[ti] * rs * nw; ov[0] *= g0; ov[1] *= g1; ov[2] *= g2; ov[3] *= g3;
            u32x2 w2; w2.x = pk2(ov[0], ov[1]); w2.y = pk2(ov[2], ov[3]);
            *(u32x2*)(P.Y + (rowbase + t0 + 16 * ti + l15) * D + 512 + ycol) = w2; }
    }
}


DI void prep_ssd(const MixL& P, int b, int c) {
    int tid_l = threadIdx.x; asm volatile("" : "+v"(tid_l));
    const int tid = tid_l, lane = tid & 63, wave = __builtin_amdgcn_readfirstlane(tid >> 6);
    const size_t rowbase = (size_t)b * SEQ; const int t0 = c * 64;
    if (tid < 480) {
        const int cgi = tid % 96, r5 = tid / 96, c0 = 8 * cgi;
        float w[4][8], bias[8];
#pragma unroll
        for (int k = 0; k < 4; ++k) { const f32x4 w0 = *(const f32x4*)(P.conv_w + k * 768 + c0), w1 = *(const f32x4*)(P.conv_w + k * 768 + c0 + 4);
            w[k][0] = w0[0]; w[k][1] = w0[1]; w[k][2] = w0[2]; w[k][3] = w0[3]; w[k][4] = w1[0]; w[k][5] = w1[1]; w[k][6] = w1[2]; w[k][7] = w1[3]; }
        { const f32x4 b0 = *(const f32x4*)(P.conv_b + c0), b1 = *(const f32x4*)(P.conv_b + c0 + 4);
          bias[0] = b0[0]; bias[1] = b0[1]; bias[2] = b0[2]; bias[3] = b0[3]; bias[4] = b1[0]; bias[5] = b1[1]; bias[6] = b1[2]; bias[7] = b1[3]; }
        const bf16_t* src = P.proj + rowbase * PL + 512 + c0;
        u32x4 nxt[7];
#pragma unroll
        for (int i = 0; i < 7; ++i) { const int tok = t0 + 4 * r5 - 3 + i; nxt[i] = (tok >= 0) ? *(const u32x4*)(src + (size_t)tok * PL) : (u32x4){0u, 0u, 0u, 0u}; }
#pragma unroll 1
        for (int run = r5; run < 16; run += 5) {
            u32x4 raw[7];
#pragma unroll
            for (int i = 0; i < 7; ++i) raw[i] = nxt[i];
            if (run + 5 < 16) {
#pragma unroll
                for (int i = 0; i < 7; ++i) nxt[i] = *(const u32x4*)(src + (size_t)(t0 + 4 * (run + 5) - 3 + i) * PL); }
            u32x4 rv[4];
#pragma unroll
            for (int jp = 0; jp < 2; ++jp) {
                float v0[8], v1[8];
#pragma unroll
                for (int e = 0; e < 8; ++e) { float a0 = bias[e], a1 = bias[e];
#pragma unroll
                    for (int k = 0; k < 4; ++k) {
                        const unsigned d0 = raw[2 * jp + k][e >> 1], d1 = raw[2 * jp + 1 + k][e >> 1];
                        const float f0 = (e & 1) ? __uint_as_float(d0 & 0xffff0000u) : __uint_as_float(d0 << 16);
                        const float f1 = (e & 1) ? __uint_as_float(d1 & 0xffff0000u) : __uint_as_float(d1 << 16);
                        a0 += w[k][e] * f0; a1 += w[k][e] * f1; }
                    v0[e] = silu_f(a0); v1[e] = silu_f(a1); }
#pragma unroll
                for (int e2 = 0; e2 < 4; ++e2) { rv[2 * jp][e2] = pk2(v0[2 * e2], v0[2 * e2 + 1]); rv[2 * jp + 1][e2] = pk2(v1[2 * e2], v1[2 * e2 + 1]); }
            }
#pragma unroll
            for (int j = 0; j < 4; ++j) *(u32x4*)(P.XA + (rowbase + t0 + 4 * run + j) * 768 + c0) = rv[j];
        }
    }
    {
        float* dta = P.DTA + (size_t)(b * 32 + c) * 2048; const int hd = wave;
        const float x = bf2f(P.proj[(rowbase + t0 + lane) * PL + 3328 + hd]) + P.dt_bias[hd];
        const float dt = (x > 20.f) ? x : log1pf(__expf(x));
        float a = dt * (-__expf(P.a_log[hd]));
#pragma unroll
        for (int o = 1; o < 64; o <<= 1) { const float v = __shfl_up(a, o); if (lane >= o) a += v; }
        const float aend = __shfl(a, 63);
        dta[hd * 64 + lane] = a * 1.44269504089f  ; dta[512 + hd * 64 + lane] = dt; dta[1024 + hd * 64 + lane] = __expf(a); dta[1536 + hd * 64 + lane] = dt * __expf(aend - a);
    }
}

__global__ void __launch_bounds__(NTHR, 2) hymba_fwd(Args a) {
    extern __shared__ __attribute__((aligned(16))) unsigned char lds_raw[];
    LAS unsigned char* lds = (LAS unsigned char*)lds_raw;
    cg::grid_group grid = cg::this_grid();
#define GSYNC0() do { asm volatile("s_waitcnt vmcnt(0) lgkmcnt(0)" ::: "memory"); grid.sync(); __builtin_amdgcn_fence(__ATOMIC_ACQUIRE, "agent"); asm volatile("s_waitcnt vmcnt(0)" ::: "memory"); } while (0)
#define GSYNC() do { XcdBarrier b_; b_.bar = (unsigned*)a.ws; b_.x = xb_xcc_id(); b_.st = (volatile LAS unsigned*)(lds + MISC_OFF) + 8; xcd_barrier(b_); } while (0)
    const int tid = threadIdx.x, lane = tid & 63, wave = __builtin_amdgcn_readfirstlane(tid >> 6);
    const int G = gridDim.x, gw = blockIdx.x * NWAVES + wave, NGW = G * NWAVES;
    unsigned char* ws = a.ws;
    float* ssq = (float*)(ws + WS_SSQ);
    bf16_t* XB = (bf16_t*)(ws + WS_XB); bf16_t* YB = (bf16_t*)(ws + WS_Y); bf16_t* RB = (bf16_t*)(ws + WS_R);
    float* out = a.out;

    { volatile LAS unsigned* MISC = (volatile LAS unsigned*)(lds + MISC_OFF); if (tid < 64) MISC[tid] = 0u; }
    __syncthreads();
    (void)xcd_barrier_post((unsigned*)ws, (volatile LAS unsigned*)(lds + MISC_OFF) + 8);
    prologue(a, lds, gw, NGW, lane, wave);
    GSYNC0();

#pragma unroll 1
    for (int ph = 0; ph < DEPTH * 8; ++ph) {
        const int l = ph >> 3, k = ph & 7;
        unsigned char* wl = ws + WS_W + (size_t)l * W_LAYER;
        if (k == 0 || k == 6) {
#ifndef NO_GU
            pg8::Gemm g{XB, (const bf16_t*)(wl + (k == 0 ? W_GU1 : W_GU2)), M, NGU, D}; pg8::StaticOrder S; S.init(M, NGU, G, (int)blockIdx.x);
            pg8::EpiGU E{RB, ssq + (size_t)(3 * l + (k == 0 ? 0 : 2)) * M * 16, FF, lds + RSC_OFF + tid * 32, -1};
            pg8::gemm_phase<pg8::EpiGU, pg8::StaticOrder, true, true>(lds, g, S, E);
#endif
        } else if (k == 1 || k == 5 || k == 7) {
#ifndef NO_RES
            const int KK = (k == 5) ? D : FF;
            pg8::Gemm g{k == 5 ? YB : RB, (const bf16_t*)(wl + (k == 1 ? W_D1 : (k == 5 ? W_OUT : W_D2))), M, D, KK}; pg8::RevOrder S; S.init(M, D, G, (int)blockIdx.x);
            pg8::EpiRes E{XB, ssq + (size_t)(3 * l + (k == 1 ? 1 : (k == 5 ? 2 : 3))) * M * 16, k == 5 ? 1.0f : 0.5f};
            pg8::gemm_phase<pg8::EpiRes, pg8::RevOrder, true, true>(lds, g, S, E);
#endif
        } else if (k == 2) {
#ifndef NO_PROJ
            pg8::Gemm g{XB, (const bf16_t*)(wl + W_IN), M, PL, D}; pg8::StaticOrder S; S.init(M, PL, G, (int)blockIdx.x);
            pg8::EpiProj E{RB, ssq + (size_t)(3 * l + 1) * M * 16, PL, lds + RSC_OFF + tid * 32, (const float*)(ws + WS_LB) + l * 512, -1};
            pg8::gemm_phase<pg8::EpiProj, pg8::StaticOrder, true, true>(lds, g, S, E);
#endif
        } else {
            MixL P{RB, YB, (bf16_t*)out  , (float*)(ws + WS_DTA), (float*)(ws + WS_EBV), a.in[7] + (size_t)l * 4 * 768, a.in[8] + (size_t)l * 768, a.in[9] + l * 8, a.in[10] + l * 8, a.in[11] + l * 8, a.in[12] + l * 512,
                   (const float*)(ws + WS_LB) + l * 512, a.in[14] + l * 64};
            if (k == 3) {
                for (int u = blockIdx.x; u < 1024; u += G) prep_ssd(P, u >> 5, u & 31);
            } else {
                if (l + 1 < DEPTH && (G <= 192 || (int)blockIdx.x >= 192)) {
                    const int cb = G > 192 ? (int)blockIdx.x - 192 : (int)blockIdx.x, cn = G > 192 ? G - 192 : G;
                    convert_layer(a, l + 1, lds, cb * NWAVES + wave, cn * NWAVES, lane, wave); __syncthreads(); }
                for (int u = blockIdx.x; u < 192; u += G) {
#ifndef NO_SSD
                    if (u < 64) ssd_unit(lds, P, u >> 1, u & 1);
#endif
#ifndef NO_HG
                    if (u >= 64) hg_unit(lds, P, u - 64);
#endif
                    __syncthreads(); }
            }
        }
        GSYNC();
    }
    { const float* fn = a.in[20]; const float* sq = ssq + (size_t)12 * M * 16;
      for (int m = gw; m < M; m += NGW) { const float rs = pg8::row_rs(sq, (unsigned)m);
          const u32x4* xr = (const u32x4*)(XB + (size_t)m * D); f32x4* orow = (f32x4*)(out + (size_t)m * D);
#pragma unroll
          for (int hlf = 0; hlf < 2; ++hlf) { const u32x4 bv = xr[64 * hlf + lane]; const f32x4 w0 = ((const f32x4*)fn)[2 * (64 * hlf + lane)], w1 = ((const f32x4*)fn)[2 * (64 * hlf + lane) + 1];
              const f32x4 b0 = {__uint_as_float(bv.x << 16), __uint_as_float(bv.x & 0xffff0000u), __uint_as_float(bv.y << 16), __uint_as_float(bv.y & 0xffff0000u)};
              const f32x4 b1 = {__uint_as_float(bv.z << 16), __uint_as_float(bv.z & 0xffff0000u), __uint_as_float(bv.w << 16), __uint_as_float(bv.w & 0xffff0000u)};
              orow[2 * (64 * hlf + lane)] = b0 * rs * w0; orow[2 * (64 * hlf + lane) + 1] = b1 * rs * w1; } } }
}

extern "C" void kernel_launch(void* const* d_in, const int* in_sizes, int n_in, void* d_out, int out_size, void* d_ws, size_t ws_size, hipStream_t stream) {
    static int grid = 0;
    if (grid == 0) {
        if (n_in != 21 || in_sizes[0] != M * D || out_size != M * D || ws_size < WS_END) { fprintf(stderr, "kernel_launch: unexpected shapes (n_in %d, in0 %d, out %d, ws %zu); nothing launched\n", n_in, n_in > 0 ? in_sizes[0] : -1, out_size, ws_size); grid = -1; return; }
        int dev = 0, cus = 0, per_cu = 0;
        if (hipGetDevice(&dev) != hipSuccess || hipDeviceGetAttribute(&cus, hipDeviceAttributeMultiprocessorCount, dev) != hipSuccess) { fprintf(stderr, "kernel_launch: device query failed\n"); grid = -1; return; }
        if (hipFuncSetAttribute((const void*)hymba_fwd, hipFuncAttributeMaxDynamicSharedMemorySize, LDS_BYTES) != hipSuccess) { fprintf(stderr, "kernel_launch: hipFuncSetAttribute failed\n"); grid = -1; return; }
        if (hipOccupancyMaxActiveBlocksPerMultiprocessor(&per_cu, (const void*)hymba_fwd, NTHR, LDS_BYTES) != hipSuccess || per_cu < 1) { fprintf(stderr, "kernel_launch: occupancy query gave %d\n", per_cu); per_cu = 1; }
        (void)hipGetLastError();
        grid = cus;
    }
    if (grid < 0) return;
    if (hipMemsetAsync(d_ws, 0, 16384, stream) != hipSuccess) { fprintf(stderr, "kernel_launch: hipMemsetAsync failed\n"); return; }
    Args a{};
    for (int i = 0; i < 21; ++i) a.in[i] = (const float*)d_in[i];
    a.out = (float*)d_out; a.ws = (unsigned char*)d_ws;
    void* args[] = {&a};
    const hipError_t e = hipLaunchCooperativeKernel((const void*)hymba_fwd, dim3(grid), dim3(NTHR), args, LDS_BYTES, stream);
    if (e != hipSuccess) fprintf(stderr, "kernel_launch: cooperative launch failed: %s (grid %d)\n", hipGetErrorString(e), grid);
}
```
